# Optimizing an MI355X kernel written in HIP

```python
import math
import jax, jax.numpy as jnp
from jax import lax
import numpy as np

D_MODEL = 2048
BATCH = 1
SEQ = 16384
DEPTH = 1

CHUNK = 64
Q_BLOCK = 128
ATTN_WIDTH = D_MODEL // 2
SSM_WIDTH = D_MODEL - ATTN_WIDTH
N_HEADS = 8
HEAD_DIM = ATTN_WIDTH // (2 * N_HEADS)
V_DIM = 2 * HEAD_DIM
ROT_DIM = HEAD_DIM // 4
ROPE_THETA = 500000.0
SSM_GROUP = 16
N_SSM_GROUPS = SSM_WIDTH // SSM_GROUP
SSM_STATE = 64
D_FF = 256 * ((8 * D_MODEL // 3 + 255) // 256)
IN_COLS = 3 * ATTN_WIDTH + SSM_WIDTH
N_MOD = 9
EPS = 1e-6
NEG_INF = -1e30

kernel_name = "hymba_diffattn_s5_macaron_block"


def rms_norm(x, g):
    xf = x.astype(jnp.float32)
    y = xf * lax.rsqrt(jnp.mean(xf * xf, axis=-1, keepdims=True) + EPS)
    return (y * g.astype(jnp.float32)).astype(x.dtype)


def modulate(h, shift, scale):
    return h * (1 + scale[:, None, :]) + shift[:, None, :]


def swiglu(h, w1, w3, w2):
    return (jax.nn.silu(h @ w1) * (h @ w3)) @ w2


def rope_partial(x, cos, sin):
    half = ROT_DIM // 2
    x1, x2, xp = x[..., :half], x[..., half:ROT_DIM], x[..., ROT_DIM:]
    c = cos[:, :, None, None, :]
    s = sin[:, :, None, None, :]
    rot = jnp.concatenate([x1 * c - x2 * s, x1 * s + x2 * c], axis=-1).astype(x.dtype)
    return jnp.concatenate([rot, xp], axis=-1)


def diff_attention(q, k, v, chunk_id, lam, lam_init, subln_g):
    B, L = q.shape[0], q.shape[1]
    nb = L // Q_BLOCK
    qb = q.reshape(B, nb, Q_BLOCK, N_HEADS, 2, HEAD_DIM).transpose(1, 0, 2, 3, 4, 5)
    cb = chunk_id.reshape(B, nb, Q_BLOCK).transpose(1, 0, 2)
    scale = HEAD_DIM ** -0.5

    def one_block(args):
        q_blk, c_blk = args
        s = jnp.einsum('bqhcd,bkhcd->bhcqk', q_blk, k).astype(jnp.float32) * scale
        mask = chunk_id[:, None, :] <= c_blk[:, :, None]
        s = jnp.where(mask[:, None, None, :, :], s, NEG_INF)
        p = jax.nn.softmax(s, axis=-1)
        a = p[:, :, 0] - lam * p[:, :, 1]
        return jnp.einsum('bhqk,bkhe->bqhe', a.astype(v.dtype), v)

    o = lax.map(one_block, (qb, cb))
    o = o.transpose(1, 0, 2, 3, 4).reshape(B, L, N_HEADS, V_DIM)
    o = rms_norm(o, subln_g) * (1.0 - lam_init)
    return o.reshape(B, L, ATTN_WIDTH)


def s5_ssm(u, a_re, a_im, log_dt, b_re, b_im, c_re, c_im, d_skip):
    f32 = jnp.float32
    B, L = u.shape[0], u.shape[1]
    ug = u.astype(f32).reshape(B, L, N_SSM_GROUPS, SSM_GROUP)
    lam = lax.complex(jnp.minimum(a_re.astype(f32), -1e-4), a_im.astype(f32))
    dt = jnp.exp(log_dt.astype(f32))[:, None]
    lam_bar = jnp.exp(lam * dt)
    b = lax.complex(b_re.astype(f32), b_im.astype(f32))
    b_bar = ((lam_bar - 1.0) / lam)[..., None] * b
    bu = jnp.einsum('gpc,blgc->blgp', b_bar, ug.astype(jnp.complex64))
    a_elems = jnp.broadcast_to(lam_bar, bu.shape)

    def combine(e1, e2):
        a1, s1 = e1
        a2, s2 = e2
        return a2 * a1, a2 * s1 + s2

    _, states = lax.associative_scan(combine, (a_elems, bu), axis=1)
    y = (jnp.einsum('gcp,blgp->blgc', c_re.astype(f32), jnp.real(states))
         - jnp.einsum('gcp,blgp->blgc', c_im.astype(f32), jnp.imag(states)))
    y = y + d_skip.astype(f32) * ug
    return y.reshape(B, L, SSM_WIDTH).astype(u.dtype)


def setup_inputs(seed: int = 0) -> dict:
    key = jax.random.key(seed)
    ks = iter(jax.random.split(key, 40))
    f32 = jnp.float32

    def nrm(shape, scale):
        return jax.random.normal(next(ks), shape, f32) * scale

    def gain(shape):
        return 1.0 + 0.02 * jax.random.normal(next(ks), shape, f32)

    x = nrm((BATCH, SEQ, D_MODEL), 1.0)
    c = nrm((BATCH, D_MODEL), 1.0)
    offset = jax.random.randint(next(ks), (BATCH, 1), 0, 64, dtype=jnp.int32) * CHUNK
    positions = (offset + jnp.arange(SEQ, dtype=jnp.int32)[None, :]).astype(jnp.int32)

    w_ada = nrm((DEPTH, D_MODEL, N_MOD * D_MODEL), D_MODEL ** -0.5)
    b_ada = nrm((DEPTH, N_MOD * D_MODEL), 0.02)

    ffn1_norm = gain((DEPTH, D_MODEL))
    ffn1_w1 = nrm((DEPTH, D_MODEL, D_FF), D_MODEL ** -0.5)
    ffn1_w3 = nrm((DEPTH, D_MODEL, D_FF), D_MODEL ** -0.5)
    ffn1_w2 = nrm((DEPTH, D_FF, D_MODEL), D_FF ** -0.5)

    mix_norm = gain((DEPTH, D_MODEL))
    w_in = nrm((DEPTH, D_MODEL, IN_COLS), D_MODEL ** -0.5)
    q_norm = gain((DEPTH, HEAD_DIM))
    k_norm = gain((DEPTH, HEAD_DIM))
    lambda_q1 = nrm((DEPTH, HEAD_DIM), 0.1)
    lambda_k1 = nrm((DEPTH, HEAD_DIM), 0.1)
    lambda_q2 = nrm((DEPTH, HEAD_DIM), 0.1)
    lambda_k2 = nrm((DEPTH, HEAD_DIM), 0.1)
    attn_subln = gain((DEPTH, V_DIM))

    n_idx = jnp.arange(SSM_STATE, dtype=f32)
    ssm_a_re = -0.5 + nrm((DEPTH, N_SSM_GROUPS, SSM_STATE), 0.01)
    ssm_a_im = math.pi * n_idx + nrm((DEPTH, N_SSM_GROUPS, SSM_STATE), 0.01)
    ssm_log_dt = jax.random.uniform(next(ks), (DEPTH, N_SSM_GROUPS), f32,
                                    math.log(1e-3), math.log(1e-1))
    ssm_b_re = nrm((DEPTH, N_SSM_GROUPS, SSM_STATE, SSM_GROUP), (2 * SSM_GROUP) ** -0.5)
    ssm_b_im = nrm((DEPTH, N_SSM_GROUPS, SSM_STATE, SSM_GROUP), (2 * SSM_GROUP) ** -0.5)
    ssm_c_re = nrm((DEPTH, N_SSM_GROUPS, SSM_GROUP, SSM_STATE), (2 * SSM_STATE) ** -0.5)
    ssm_c_im = nrm((DEPTH, N_SSM_GROUPS, SSM_GROUP, SSM_STATE), (2 * SSM_STATE) ** -0.5)
    ssm_d = nrm((DEPTH, N_SSM_GROUPS, SSM_GROUP), 1.0)
    w_glu = nrm((DEPTH, SSM_WIDTH, SSM_WIDTH), SSM_WIDTH ** -0.5)
    b_glu = nrm((DEPTH, SSM_WIDTH), 0.02)
    ssm_out_norm = gain((DEPTH, SSM_WIDTH))
    w_out = nrm((DEPTH, D_MODEL, D_MODEL), D_MODEL ** -0.5)

    ffn2_norm = gain((DEPTH, D_MODEL))
    ffn2_w1 = nrm((DEPTH, D_MODEL, D_FF), D_MODEL ** -0.5)
    ffn2_w3 = nrm((DEPTH, D_MODEL, D_FF), D_MODEL ** -0.5)
    ffn2_w2 = nrm((DEPTH, D_FF, D_MODEL), D_FF ** -0.5)

    return {"x": x, "c": c, "positions": positions, "w_ada": w_ada, "b_ada": b_ada,
            "ffn1_norm": ffn1_norm, "ffn1_w1": ffn1_w1, "ffn1_w3": ffn1_w3, "ffn1_w2": ffn1_w2,
            "mix_norm": mix_norm, "w_in": w_in, "q_norm": q_norm, "k_norm": k_norm,
            "lambda_q1": lambda_q1, "lambda_k1": lambda_k1, "lambda_q2": lambda_q2,
            "lambda_k2": lambda_k2, "attn_subln": attn_subln,
            "ssm_a_re": ssm_a_re, "ssm_a_im": ssm_a_im, "ssm_log_dt": ssm_log_dt,
            "ssm_b_re": ssm_b_re, "ssm_b_im": ssm_b_im, "ssm_c_re": ssm_c_re,
            "ssm_c_im": ssm_c_im, "ssm_d": ssm_d, "w_glu": w_glu, "b_glu": b_glu,
            "ssm_out_norm": ssm_out_norm, "w_out": w_out,
            "ffn2_norm": ffn2_norm, "ffn2_w1": ffn2_w1, "ffn2_w3": ffn2_w3, "ffn2_w2": ffn2_w2}


def reference(x, c, positions, w_ada, b_ada, ffn1_norm, ffn1_w1, ffn1_w3, ffn1_w2,
              mix_norm, w_in, q_norm, k_norm, lambda_q1, lambda_k1, lambda_q2, lambda_k2,
              attn_subln, ssm_a_re, ssm_a_im, ssm_log_dt, ssm_b_re, ssm_b_im, ssm_c_re,
              ssm_c_im, ssm_d, w_glu, b_glu, ssm_out_norm, w_out,
              ffn2_norm, ffn2_w1, ffn2_w3, ffn2_w2):
    f32 = jnp.float32
    B, L, _ = x.shape
    chunk_id = positions // CHUNK
    inv_freq = ROPE_THETA ** (-jnp.arange(0, ROT_DIM, 2, dtype=f32) / ROT_DIM)
    ang = positions.astype(f32)[..., None] * inv_freq
    cos, sin = jnp.cos(ang), jnp.sin(ang)
    cond = jax.nn.silu(c)

    for l in range(DEPTH):
        lam_init = 0.8 - 0.6 * math.exp(-0.3 * l)
        mod = cond @ w_ada[l] + b_ada[l]
        sh1, sc1, g1, sh2, sc2, g2, sh3, sc3, g3 = jnp.split(mod, N_MOD, axis=-1)

        h = modulate(rms_norm(x, ffn1_norm[l]), sh1, sc1)
        x = x + 0.5 * g1[:, None, :] * swiglu(h, ffn1_w1[l], ffn1_w3[l], ffn1_w2[l])

        h = modulate(rms_norm(x, mix_norm[l]), sh2, sc2)
        proj = h @ w_in[l]
        q = proj[..., :ATTN_WIDTH].reshape(B, L, N_HEADS, 2, HEAD_DIM)
        k = proj[..., ATTN_WIDTH:2 * ATTN_WIDTH].reshape(B, L, N_HEADS, 2, HEAD_DIM)
        v = proj[..., 2 * ATTN_WIDTH:3 * ATTN_WIDTH].reshape(B, L, N_HEADS, V_DIM)
        u = proj[..., 3 * ATTN_WIDTH:]

        q = rope_partial(rms_norm(q, q_norm[l]), cos, sin)
        k = rope_partial(rms_norm(k, k_norm[l]), cos, sin)
        lam = (jnp.exp(jnp.sum(lambda_q1[l].astype(f32) * lambda_k1[l].astype(f32)))
               - jnp.exp(jnp.sum(lambda_q2[l].astype(f32) * lambda_k2[l].astype(f32)))
               + lam_init)
        attn_out = diff_attention(q, k, v, chunk_id, lam, lam_init, attn_subln[l])

        y = s5_ssm(u, ssm_a_re[l], ssm_a_im[l], ssm_log_dt[l], ssm_b_re[l], ssm_b_im[l],
                   ssm_c_re[l], ssm_c_im[l], ssm_d[l])
        y = jax.nn.gelu(y)
        y = y * jax.nn.sigmoid(y @ w_glu[l] + b_glu[l])
        y = rms_norm(y, ssm_out_norm[l])

        mixed = jnp.concatenate([attn_out, y], axis=-1) @ w_out[l]
        x = x + g2[:, None, :] * mixed

        h = modulate(rms_norm(x, ffn2_norm[l]), sh3, sc3)
        x = x + 0.5 * g3[:, None, :] * swiglu(h, ffn2_w1[l], ffn2_w3[l], ffn2_w2[l])
    return x
```

```cpp
#include <hip/hip_runtime.h>
#include <hip/hip_cooperative_groups.h>
#include <hip/hip_bf16.h>
#include <cstdio>
#include <cstdint>
#include <cmath>
namespace cg = cooperative_groups;
__device__ __forceinline__ int lane_asm() { int l; asm volatile("v_mbcnt_lo_u32_b32 %0, -1, 0\n\tv_mbcnt_hi_u32_b32 %0, -1, %0" : "=v"(l)); return l; }

namespace pg8 {
#define PG8_LAS __attribute__((address_space(3)))
typedef unsigned short bf16_t;
typedef short bf16x8 __attribute__((ext_vector_type(8)));
typedef float f32x4 __attribute__((ext_vector_type(4)));
typedef unsigned u32x4 __attribute__((ext_vector_type(4)));
constexpr int BM = 256, BK = 64, HALF = 128, HTB = HALF * BK * 2  , STAGE_BYTES = 8 * HTB, NXCD = 8, WGM = 8;

__host__ __device__ __forceinline__ int lds_byte(int r, int c) { const int st = (r >> 4) * 2 + (c >> 5), rr = r & 15, cc = c & 31, ob = rr * 64 + cc * 2; return st * 1024 + (ob ^ (((ob >> 9) & 1) << 5)); }
__host__ __device__ __forceinline__ void stage_rc(int b, int& R, int& C) { const int st = b / 1024, sb = b % 1024, swz = sb ^ (((sb >> 9) & 1) << 5); R = (st >> 1) * 16 + swz / 64; C = (st & 1) * 32 + (swz % 64) / 2; }
__host__ __device__ __forceinline__ int perm32(int rho) { const int n = rho >> 4, i = rho & 15; return 8 * (i >> 2) + 4 * n + (i & 3); }

struct Unit { int pm, pn, pz; };
struct Gemm { const bf16_t* A; const bf16_t* Bt; int lda, ldb, K; size_t azs, bzs; };

struct StaticOrder {
    int nM, nN, nwg, G, c;
    __host__ __device__ void init(int M, int N, int G_, int c_) { nM = M / BM; nN = N / BM; nwg = nM * nN; G = G_; c = c_; }
    __host__ __device__ bool next(int i, Unit& u) const {
        const long L = (long)i * G + c; if (L >= nwg) return false;
        int wgid = (int)L; { const int q = nwg / NXCD, r = nwg % NXCD, xcd = wgid % NXCD, off = wgid / NXCD; wgid = (xcd < r ? xcd * (q + 1) : r * (q + 1) + (xcd - r) * q) + off; }
        const int nig = WGM * nN, gid = wgid / nig, fm = gid * WGM, gsz = (nM - fm) < WGM ? (nM - fm) : WGM;
        u.pm = fm + ((wgid % nig) % gsz); u.pn = (wgid % nig) / gsz; u.pz = 0; return true;
    }
};
struct BatchOrder {
    int nM, nun, G, c;
    __host__ __device__ void init(int nM_, int nZ, int G_, int c_) { nM = nM_; nun = nM_ * nZ; G = G_; c = c_; }
    __host__ __device__ bool next(int i, Unit& u) const { const long L = (long)i * G + c; if (L >= nun) return false; u.pz = (int)L / nM; u.pm = (int)L % nM; u.pn = 0; return true; }
};

__device__ __forceinline__ unsigned cvt_pk_bf16(float lo, float hi) { unsigned r; asm volatile("v_cvt_pk_bf16_f32 %0, %1, %2" : "=v"(r) : "v"(lo), "v"(hi)); return r; }
__device__ __forceinline__ float bf_lo(unsigned w) { return __uint_as_float(w << 16); }
__device__ __forceinline__ float bf_hi(unsigned w) { return __uint_as_float(w & 0xffff0000u); }
__device__ __forceinline__ float sigmoid_f(float a) { return __builtin_amdgcn_rcpf(1.0f + __builtin_amdgcn_exp2f(-1.4426950408889634f * a)); }
__device__ __forceinline__ float silu_f(float a) { return a * sigmoid_f(a); }
__device__ __forceinline__ float gelu_tanh_f(float v) {
    const float z = 0.7978845608028654f * (v + 0.044715f * v * v * v); return v * sigmoid_f(2.0f * z);
}
__device__ __forceinline__ u32x4 pack8(const f32x4& v0, const f32x4& v1) { u32x4 w; w.x = cvt_pk_bf16(v0[0], v0[1]); w.y = cvt_pk_bf16(v0[2], v0[3]); w.z = cvt_pk_bf16(v1[0], v1[1]); w.w = cvt_pk_bf16(v1[2], v1[3]); return w; }

__device__ __forceinline__ float rstd_from_ssq(const unsigned long long* ssq, int row) {
    return 1.0f / sqrtf((float)ssq[row] * (1.0f / 16777216.0f) * (1.0f / 2048.0f) + 1e-6f);
}
typedef float f32x2 __attribute__((ext_vector_type(2)));
__device__ __forceinline__ f32x4 swiglu4(const f32x4 a, const f32x4 b) {
    const f32x4 t = a * (-1.4426950408889634f); f32x4 e;
#pragma unroll
    for (int k = 0; k < 4; ++k) e[k] = __builtin_amdgcn_exp2f(t[k]);
    e = e + 1.0f;
#pragma unroll
    for (int k = 0; k < 4; ++k) e[k] = __builtin_amdgcn_rcpf(e[k]);
    return (a * e) * b;
}
template <bool DEFER> struct EpiSwiGLU {
    static constexpr bool PERM = true;
    bf16_t* O; int ldc; const unsigned long long* ssq; const float* bv;
    __device__ __forceinline__ void operator()(const f32x4 (&acc)[2][2][4][2], const Unit& u, int wr, int wc, int fr_, int fq_) const {
        const int l_ = lane_asm(); const int fr = l_ & 15, fq = l_ >> 4; (void)fr_; (void)fq_;
        const int row0 = u.pm * BM + wr * 64 + fr, col0 = u.pn * HALF + wc * 32 + 8 * fq;
        f32x4 ba0 = {0.f, 0.f, 0.f, 0.f}, ba1 = ba0, bb0 = ba0, bb1 = ba0;
        if constexpr (DEFER) { const float* bp = bv + u.pn * BM + wc * 32 + 8 * fq; ba0 = *(const f32x4*)bp; ba1 = *(const f32x4*)(bp + 4); bb0 = *(const f32x4*)(bp + HALF); bb1 = *(const f32x4*)(bp + HALF + 4); }
        float rsv[8];
        if constexpr (DEFER) {
#pragma unroll
            for (int i = 0; i < 8; ++i) rsv[i] = rstd_from_ssq(ssq, row0 + (i >> 2) * HALF + (i & 3) * 16);
            asm volatile("" ::: "memory"); }
#pragma unroll
        for (int ai = 0; ai < 2; ++ai)
#pragma unroll
            for (int m = 0; m < 4; ++m) { const int row = row0 + ai * HALF + m * 16; bf16_t* rowp = O + (size_t)row * ldc + col0;
                f32x4 v0, v1;
                if constexpr (DEFER) { const float rs = rsv[ai * 4 + m];
                    v0 = swiglu4(acc[ai][0][m][0] * rs + ba0, acc[ai][1][m][0] * rs + bb0); v1 = swiglu4(acc[ai][0][m][1] * rs + ba1, acc[ai][1][m][1] * rs + bb1); }
                else { v0 = swiglu4(acc[ai][0][m][0], acc[ai][1][m][0]); v1 = swiglu4(acc[ai][0][m][1], acc[ai][1][m][1]); }
                *(u32x4*)rowp = pack8(v0, v1); }
    }
};
template <bool EMIT> struct EpiResid {
    static constexpr bool PERM = false;
    const float* base; float* out; int ldc; const float* gate;
    bf16_t* A2; const float* gmv; unsigned long long* ssq;
    __device__ __forceinline__ void operator()(const f32x4 (&acc)[2][2][4][2], const Unit& u, int wr, int wc, int fr_, int fq_) const {
        const int l_ = lane_asm(); const int fr = l_ & 15, fq = l_ >> 4; (void)fr_; (void)fq_;
        const int row0 = u.pm * BM + wr * 64 + fr, col0 = u.pn * BM + wc * 32 + 4 * fq;
        f32x4 gv[2][2], gm[2][2];
#pragma unroll
        for (int bj = 0; bj < 2; ++bj)
#pragma unroll
            for (int n = 0; n < 2; ++n) { gv[bj][n] = *(const f32x4*)(gate + col0 + bj * HALF + n * 16);
                if constexpr (EMIT) gm[bj][n] = *(const f32x4*)(gmv + col0 + bj * HALF + n * 16); else gm[bj][n] = gv[bj][n]; }
#pragma unroll
        for (int ai = 0; ai < 2; ++ai)
#pragma unroll
        for (int mh = 0; mh < 2; ++mh) {
            f32x4 bs[2][2][2];
#pragma unroll
            for (int m = 0; m < 2; ++m) { const size_t off = (size_t)(row0 + ai * HALF + (2 * mh + m) * 16) * ldc + col0;
#pragma unroll
                for (int bj = 0; bj < 2; ++bj)
#pragma unroll
                    for (int n = 0; n < 2; ++n) bs[m][bj][n] = *(const f32x4*)(base + off + bj * HALF + n * 16); }
            asm volatile("" ::: "memory");
#pragma unroll
            for (int m = 0; m < 2; ++m) { const int row = row0 + ai * HALF + (2 * mh + m) * 16; const size_t off = (size_t)row * ldc + col0; float ss = 0.f;
#pragma unroll
                for (int bj = 0; bj < 2; ++bj)
#pragma unroll
                    for (int n = 0; n < 2; ++n) { const f32x4 o = bs[m][bj][n] + gv[bj][n] * acc[ai][bj][2 * mh + m][n]; *(f32x4*)(out + off + bj * HALF + n * 16) = o;
                        if constexpr (EMIT) { ss += (o[0] * o[0] + o[1] * o[1]) + (o[2] * o[2] + o[3] * o[3]); const f32x4 y = o * gm[bj][n];
                            typedef unsigned u32x2_t __attribute__((ext_vector_type(2))); u32x2_t w; w.x = cvt_pk_bf16(y[0], y[1]); w.y = cvt_pk_bf16(y[2], y[3]); *(u32x2_t*)(A2 + off + bj * HALF + n * 16) = w; } }
                if constexpr (EMIT) { ss += __shfl_xor(ss, 16); ss += __shfl_xor(ss, 32); if (fq == 0) atomicAdd(ssq + row, (unsigned long long)(ss * 16777216.0f)); } }
            asm volatile("" ::: "memory");
        }
    }
};
struct EpiQKVU {
    static constexpr bool PERM = true;
    bf16_t* Q; size_t qkv_stride; bf16_t* U; const float* qn; const float* kn; const float* cs; float c2; const unsigned long long* ssq; const float* bv;
    __device__ __forceinline__ void operator()(const f32x4 (&acc)[2][2][4][2], const Unit& u, int wr, int wc, int fr_, int fq_) const {
        const int l_ = lane_asm(); const int fr = l_ & 15, fq = l_ >> 4; (void)fr_; (void)fq_;
        const int row0 = u.pm * BM + wr * 64 + fr, t = u.pn >> 2;
        float rsv[8];
#pragma unroll
        for (int i = 0; i < 8; ++i) rsv[i] = rstd_from_ssq(ssq, row0 + (i >> 2) * HALF + (i & 3) * 16);
        asm volatile("" ::: "memory");
        if (t < 2) {
            f32x4 g[2][2];
#pragma unroll
            for (int bj = 0; bj < 2; ++bj)
#pragma unroll
                for (int n = 0; n < 2; ++n) { const f32x4 a = *(const f32x4*)(qn + bj * 32 + 8 * fq + 4 * n), b = *(const f32x4*)(kn + bj * 32 + 8 * fq + 4 * n); g[bj][n] = t == 0 ? a : b; }
            const float sc = t == 0 ? c2 : 1.0f;
            const float* bp = bv + u.pn * BM + wc * 32 + 8 * fq; const f32x4 b00 = *(const f32x4*)bp, b01 = *(const f32x4*)(bp + 4), b10 = *(const f32x4*)(bp + HALF), b11 = *(const f32x4*)(bp + HALF + 4);
            const unsigned long long* sp = ssq + row0;
            bf16_t* rp = Q + (size_t)t * qkv_stride + (size_t)row0 * 1024 + ((u.pn & 3) * 4 + wc) * 64 + 8 * fq;
            const float* cp = cs + (size_t)row0 * 16;
#pragma unroll
            for (int ai = 0; ai < 2; ++ai)
#pragma unroll
                for (int m = 0; m < 4; ++m) {
                    asm volatile("" : "+v"(rp), "+v"(cp), "+v"(sp));
                    const float rs = rsv[ai * 4 + m];
                    f32x4 v00 = acc[ai][0][m][0] * rs + b00, v01 = acc[ai][0][m][1] * rs + b01, v10 = acc[ai][1][m][0] * rs + b10, v11 = acc[ai][1][m][1] * rs + b11;
                    float ss = 0.f;
#pragma unroll
                    for (int k = 0; k < 4; ++k) ss += v00[k] * v00[k] + v01[k] * v01[k] + v10[k] * v10[k] + v11[k] * v11[k];
                    ss += __shfl_xor(ss, 16); ss += __shfl_xor(ss, 32);
                    const float rstd = 1.0f / sqrtf(ss * (1.0f / 64.0f) + 1e-6f);
                    v00 = v00 * rstd * g[0][0]; v01 = v01 * rstd * g[0][1]; v10 = v10 * rstd * g[1][0]; v11 = v11 * rstd * g[1][1];
                    f32x4 p0, p1;
#pragma unroll
                    for (int k = 0; k < 4; ++k) { p0[k] = __shfl_xor(v00[k], 16); p1[k] = __shfl_xor(v01[k], 16); }
                    const f32x4 c0 = *(const f32x4*)(cp), c1 = *(const f32x4*)(cp + 4), s0 = *(const f32x4*)(cp + 8), s1 = *(const f32x4*)(cp + 12);
                    if (fq < 2) {
                        if (fq == 0) { v00 = v00 * c0 - p0 * s0; v01 = v01 * c1 - p1 * s1; } else { v00 = p0 * s0 + v00 * c0; v01 = p1 * s1 + v01 * c1; } }
                    v00 = v00 * sc; v01 = v01 * sc; v10 = v10 * sc; v11 = v11 * sc;
                    *(u32x4*)rp = pack8(v00, v01); *(u32x4*)(rp + 32) = pack8(v10, v11);
                    const int adv = (m == 3) ? (128 - 48) : 16; rp += (size_t)adv * 1024; cp += (size_t)adv * 16; sp += adv; }
            return;
        }
        const int col0 = (u.pn & 3) * BM + wc * 32 + 8 * fq;
        bf16_t* base = Q + (size_t)2 * qkv_stride;
        const float* bp2 = bv + u.pn * BM + wc * 32 + 8 * fq;
        const f32x4 bq[2][2] = {{*(const f32x4*)(bp2), *(const f32x4*)(bp2 + 4)}, {*(const f32x4*)(bp2 + HALF), *(const f32x4*)(bp2 + HALF + 4)}};
        asm volatile("" ::: "memory");
#pragma unroll
        for (int ai = 0; ai < 2; ++ai)
#pragma unroll
            for (int m = 0; m < 4; ++m) { const int row = row0 + ai * HALF + m * 16;
#pragma unroll
                for (int bj = 0; bj < 2; ++bj) { const int col = col0 + bj * HALF; const float rs = rsv[ai * 4 + m];
                    const u32x4 w = pack8(acc[ai][bj][m][0] * rs + bq[bj][0], acc[ai][bj][m][1] * rs + bq[bj][1]);
                    if (t < 3) *(u32x4*)(base + (size_t)row * 1024 + col) = w;
                    else *(u32x4*)(U + ((size_t)((row >> 4) * 64 + (col >> 4)) * 384 + (row & 15) * 16 + (col & 15))) = w; } }
    }
};
struct EpiF32 {
    static constexpr bool PERM = false;
    float* out; int ldc;
    __device__ __forceinline__ void operator()(const f32x4 (&acc)[2][2][4][2], const Unit& u, int wr, int wc, int fr, int fq) const {
        const int row0 = u.pm * BM + wr * 64 + fr, col0 = u.pz * BM + wc * 32 + 4 * fq;
#pragma unroll
        for (int ai = 0; ai < 2; ++ai)
#pragma unroll
            for (int m = 0; m < 4; ++m) { const size_t off = (size_t)(row0 + ai * HALF + m * 16) * ldc + col0;
#pragma unroll
                for (int bj = 0; bj < 2; ++bj)
#pragma unroll
                    for (int n = 0; n < 2; ++n) *(f32x4*)(out + off + bj * HALF + n * 16) = acc[ai][bj][m][n]; }
    }
};
struct EpiSsmY {
    static constexpr bool PERM = true;
    const bf16_t* U; const float* dskip; bf16_t* YG;
    __device__ __forceinline__ void operator()(const f32x4 (&acc)[2][2][4][2], const Unit& u, int wr, int wc, int fr_, int fq_) const {
        const int l_ = lane_asm(); const int fr = l_ & 15, fq = l_ >> 4; (void)fr_; (void)fq_;
        const int row0 = u.pm * BM + wr * 64 + fr, g = u.pz, col0 = wc * 32 + 8 * fq, co0 = col0 & 15;
        const f32x4 d0 = *(const f32x4*)(dskip + g * 16 + co0), d1 = *(const f32x4*)(dskip + g * 16 + co0 + 4);
        const bf16_t* up = U + ((size_t)(row0 * 64 + g) * 384 + col0);
        bf16_t* yp = YG + ((size_t)row0 * 16 + (col0 >> 4)) * 1024 + g * 16 + co0;
        u32x4 uwv[2][2];
#pragma unroll
        for (int ai = 0; ai < 2; ++ai)
#pragma unroll
            for (int m = 0; m < 4; ++m) {
                asm volatile("" : "+v"(up), "+v"(yp));
                if ((m & 1) == 0) {
                    uwv[0][0] = *(const u32x4*)(up); uwv[0][1] = *(const u32x4*)(up + 128);
                    uwv[1][0] = *(const u32x4*)(up + (size_t)16 * 64 * 384); uwv[1][1] = *(const u32x4*)(up + (size_t)16 * 64 * 384 + 128);
                    asm volatile("" ::: "memory"); }
#pragma unroll
                for (int bj = 0; bj < 2; ++bj) {
                    const u32x4 uw = uwv[m & 1][bj];
                    f32x4 v0 = acc[ai][bj][m][0], v1 = acc[ai][bj][m][1];
                    v0[0] += d0[0] * bf_lo(uw.x); v0[1] += d0[1] * bf_hi(uw.x); v0[2] += d0[2] * bf_lo(uw.y); v0[3] += d0[3] * bf_hi(uw.y);
                    v1[0] += d1[0] * bf_lo(uw.z); v1[1] += d1[1] * bf_hi(uw.z); v1[2] += d1[2] * bf_lo(uw.w); v1[3] += d1[3] * bf_hi(uw.w);
#pragma unroll
                    for (int k = 0; k < 4; ++k) { v0[k] = gelu_tanh_f(v0[k]); v1[k] = gelu_tanh_f(v1[k]); }
                    *(u32x4*)(yp + bj * 8 * 1024) = pack8(v0, v1); }
                const int adv = (m == 3) ? (128 - 48) : 16;
                up += (size_t)adv * 64 * 384; yp += (size_t)adv * 16 * 1024; }
    }
};
struct EpiGlu {
    static constexpr bool PERM = true;
    const bf16_t* YG; const float* bias; bf16_t* Y2;
    __device__ __forceinline__ void operator()(const f32x4 (&acc)[2][2][4][2], const Unit& u, int wr, int wc, int fr, int fq) const {
        const int row0 = u.pm * BM + wr * 64 + fr, col0 = u.pn * BM + wc * 32 + 8 * fq;
#pragma unroll
        for (int bj = 0; bj < 2; ++bj) { const int col = col0 + bj * HALF;
            const f32x4 b0 = *(const f32x4*)(bias + col), b1 = *(const f32x4*)(bias + col + 4);
            u32x4 ywv[8];
#pragma unroll
            for (int i = 0; i < 8; ++i) ywv[i] = *(const u32x4*)(YG + (size_t)(row0 + (i >> 2) * HALF + (i & 3) * 16) * 1024 + col);
            asm volatile("" ::: "memory");
#pragma unroll
            for (int ai = 0; ai < 2; ++ai)
#pragma unroll
                for (int m = 0; m < 4; ++m) { const size_t off = (size_t)(row0 + ai * HALF + m * 16) * 1024 + col;
                    const u32x4 yw = ywv[ai * 4 + m];
                    f32x4 v0 = acc[ai][bj][m][0] + b0, v1 = acc[ai][bj][m][1] + b1;
                    v0[0] = bf_lo(yw.x) * sigmoid_f(v0[0]); v0[1] = bf_hi(yw.x) * sigmoid_f(v0[1]); v0[2] = bf_lo(yw.y) * sigmoid_f(v0[2]); v0[3] = bf_hi(yw.y) * sigmoid_f(v0[3]);
                    v1[0] = bf_lo(yw.z) * sigmoid_f(v1[0]); v1[1] = bf_hi(yw.z) * sigmoid_f(v1[1]); v1[2] = bf_lo(yw.w) * sigmoid_f(v1[2]); v1[3] = bf_hi(yw.w) * sigmoid_f(v1[3]);
                    *(u32x4*)(Y2 + off) = pack8(v0, v1); }
            asm volatile("" ::: "memory"); }
    }
};

template <class Epi, class Sched, bool ALIGN_EPI = false, bool SP2 = false>
__device__ __forceinline__ void gemm_phase(PG8_LAS unsigned char* lds, const Gemm g, const Sched& S, const Epi& E, const int wid) {
    const int lane = lane_asm(), tid = wid * 64 + lane, wr = wid >> 2, wc = wid & 3, fr = lane & 15, fq = lane >> 4;
    const int K = g.K, nt = K / BK;
    unsigned voffA[2], voffB[2];
#pragma unroll
    for (int i = 0; i < 2; ++i) { int R, C; stage_rc(tid * 16 + i * 8192, R, C); const int Rb = Epi::PERM ? ((R & ~31) + perm32(R & 31)) : R;
        voffA[i] = (unsigned)(R * g.lda + C) * 2u; voffB[i] = (unsigned)(Rb * g.ldb + C) * 2u; }
    const size_t kstep = (size_t)(BK * 2);
    const size_t hsA = (size_t)HALF * g.lda * 2, hsB = (size_t)HALF * g.ldb * 2;
#define PG8_APTR(u) ((const char*)g.A + ((size_t)(u).pz * g.azs + (size_t)(u).pm * BM * g.lda) * 2)
#define PG8_BPTR(u) ((const char*)g.Bt + ((size_t)(u).pz * g.bzs + (size_t)(u).pn * BM * g.ldb) * 2)
    const unsigned ldsw = (unsigned)wid * 1024u;
    const int aoff = lds_byte(wr * 64 + fr, fq * 8), boff = lds_byte(wc * 32 + fr, fq * 8);
#define PG8_SA(b, h) (((b) * 2 + (h)) * HTB)
#define PG8_SB(b, h) ((4 + (b) * 2 + (h)) * HTB)
#define PG8_STAGE(bufoff, gbase, voff) do { _Pragma("unroll") for (int _i = 0; _i < 2; ++_i) \
        __builtin_amdgcn_global_load_lds((const unsigned*)((const char*)(gbase) + (voff)[_i]), (PG8_LAS unsigned*)(lds + (bufoff) + ldsw + _i * 8192), 16, 0, 0); } while (0)
#define PG8_LDA(dst, b, h) do { _Pragma("unroll") for (int m = 0; m < 4; ++m) _Pragma("unroll") for (int k = 0; k < 2; ++k) dst[m][k] = *(const PG8_LAS bf16x8*)(lds + PG8_SA(b, h) + aoff + m * 2048 + k * 1024); } while (0)
#define PG8_LDB(dst, b, h) do { _Pragma("unroll") for (int n = 0; n < 2; ++n) _Pragma("unroll") for (int k = 0; k < 2; ++k) dst[n][k] = *(const PG8_LAS bf16x8*)(lds + PG8_SB(b, h) + boff + n * 2048 + k * 1024); } while (0)
#define PG8_MMA(ai, bj, At, Bt) do { __builtin_amdgcn_s_setprio(1); _Pragma("unroll") for (int m = 0; m < 4; ++m) _Pragma("unroll") for (int n = 0; n < 2; ++n) _Pragma("unroll") for (int k = 0; k < 2; ++k) \
        acc[ai][bj][m][n] = __builtin_amdgcn_mfma_f32_16x16x32_bf16(Bt[n][k], At[m][k], acc[ai][bj][m][n], 0, 0, 0); __builtin_amdgcn_s_setprio(0); } while (0)
#define PG8_WAIT_V(n) asm volatile("s_waitcnt vmcnt(" #n ")" ::: "memory")
#define PG8_WAIT_L(n) asm volatile("s_waitcnt lgkmcnt(" #n ")" ::: "memory")
#define PG8_BAR __builtin_amdgcn_s_barrier()
#define PG8_SCHED __builtin_amdgcn_sched_barrier(0)
    Unit cur, nxt; int ui = 0;
    if (!S.next(0, cur)) return;
    f32x4 acc[2][2][4][2];
#pragma unroll
    for (int a = 0; a < 2; ++a)
#pragma unroll
        for (int b = 0; b < 2; ++b)
#pragma unroll
            for (int m = 0; m < 4; ++m)
#pragma unroll
                for (int n = 0; n < 2; ++n) acc[a][b][m][n] = (f32x4){0.f, 0.f, 0.f, 0.f};
    bf16x8 At[4][2], B0[2][2], B1[2][2];
    const char* cA = PG8_APTR(cur); const char* cB = PG8_BPTR(cur);
    if constexpr (SP2) {
        PG8_STAGE(PG8_SB(0, 0), cB, voffB); PG8_STAGE(PG8_SB(0, 1), cB + hsB, voffB); PG8_STAGE(PG8_SA(0, 0), cA, voffA); PG8_STAGE(PG8_SA(0, 1), cA + hsA, voffA);
        if (wr == 1) PG8_BAR;
        PG8_WAIT_V(2); PG8_BAR;
        PG8_STAGE(PG8_SB(1, 0), cB + kstep, voffB); PG8_STAGE(PG8_SA(1, 0), cA + kstep, voffA); PG8_STAGE(PG8_SB(1, 1), cB + hsB + kstep, voffB);
        PG8_WAIT_V(6); PG8_BAR;
    } else {
        PG8_STAGE(PG8_SB(0, 0), cB, voffB); PG8_STAGE(PG8_SA(0, 0), cA, voffA); PG8_STAGE(PG8_SB(0, 1), cB + hsB, voffB); PG8_STAGE(PG8_SA(0, 1), cA + hsA, voffA);
        if (wr == 1) PG8_BAR;
        PG8_WAIT_V(4); PG8_BAR;
        PG8_STAGE(PG8_SB(1, 0), cB + kstep, voffB); PG8_STAGE(PG8_SA(1, 0), cA + kstep, voffA); PG8_STAGE(PG8_SB(1, 1), cB + hsB + kstep, voffB);
        PG8_WAIT_V(6); PG8_BAR;
    }
    for (;;) {
        const bool has_next = S.next(ui + 1, nxt);
        const char* nA = has_next ? PG8_APTR(nxt) : cA; const char* nB = has_next ? PG8_BPTR(nxt) : cB;
        for (int t = 0; t < nt; t += 2) {
            const bool last = (t == nt - 2);
            const char* a1 = cA + (size_t)(t + 1) * kstep;
            const char* a2 = last ? nA : cA + (size_t)(t + 2) * kstep; const char* b2 = last ? nB : cB + (size_t)(t + 2) * kstep;
            const char* a3 = a2 + kstep; const char* b3 = b2 + kstep;

            if constexpr (SP2) {
            PG8_LDB(B0, 0, 0); PG8_LDB(B1, 0, 1); PG8_SCHED; PG8_LDA(At, 0, 0); PG8_STAGE(PG8_SA(1, 1), a1 + hsA, voffA);
            PG8_WAIT_V(8); PG8_WAIT_L(0); PG8_BAR; PG8_MMA(0, 0, At, B0); PG8_MMA(0, 1, At, B1); PG8_BAR; PG8_SCHED;
            PG8_LDA(At, 0, 1); PG8_STAGE(PG8_SB(0, 0), b2, voffB); PG8_STAGE(PG8_SB(0, 1), b2 + hsB, voffB); PG8_STAGE(PG8_SA(0, 0), a2, voffA);
            PG8_WAIT_V(8); PG8_WAIT_L(0); PG8_BAR; PG8_MMA(1, 0, At, B0); PG8_MMA(1, 1, At, B1); PG8_BAR; PG8_SCHED;
            PG8_LDB(B0, 1, 0); PG8_LDB(B1, 1, 1); PG8_SCHED; PG8_LDA(At, 1, 0); PG8_STAGE(PG8_SA(0, 1), a2 + hsA, voffA);
            PG8_WAIT_V(8); PG8_WAIT_L(0); PG8_BAR; PG8_MMA(0, 0, At, B0); PG8_MMA(0, 1, At, B1); PG8_BAR; PG8_SCHED;
            PG8_LDA(At, 1, 1); PG8_STAGE(PG8_SB(1, 0), b3, voffB); PG8_STAGE(PG8_SB(1, 1), b3 + hsB, voffB); PG8_STAGE(PG8_SA(1, 0), a3, voffA);
            PG8_WAIT_V(8); PG8_WAIT_L(0); PG8_BAR; PG8_MMA(1, 0, At, B0); PG8_MMA(1, 1, At, B1); PG8_BAR; PG8_SCHED;
            } else {
            PG8_LDB(B0, 0, 0); PG8_SCHED; PG8_LDA(At, 0, 0); PG8_STAGE(PG8_SA(1, 1), a1 + hsA, voffA);
            PG8_WAIT_L(8); PG8_BAR; PG8_WAIT_L(0); PG8_MMA(0, 0, At, B0); PG8_BAR; PG8_SCHED;
            PG8_LDB(B1, 0, 1); PG8_STAGE(PG8_SB(0, 0), b2, voffB);
            PG8_BAR; PG8_WAIT_L(0); PG8_MMA(0, 1, At, B1); PG8_BAR;
            PG8_LDA(At, 0, 1); PG8_STAGE(PG8_SA(0, 0), a2, voffA);
            PG8_BAR; PG8_WAIT_L(0); PG8_MMA(1, 0, At, B0); PG8_BAR; PG8_SCHED;
            PG8_STAGE(PG8_SB(0, 1), b2 + hsB, voffB);
            PG8_WAIT_V(6); PG8_BAR; PG8_MMA(1, 1, At, B1); PG8_BAR;
            PG8_LDB(B0, 1, 0); PG8_SCHED; PG8_LDA(At, 1, 0); PG8_STAGE(PG8_SA(0, 1), a2 + hsA, voffA);
            PG8_WAIT_L(8); PG8_BAR; PG8_WAIT_L(0); PG8_MMA(0, 0, At, B0); PG8_BAR; PG8_SCHED;
            PG8_LDB(B1, 1, 1); PG8_STAGE(PG8_SB(1, 0), b3, voffB);
            PG8_BAR; PG8_WAIT_L(0); PG8_MMA(0, 1, At, B1); PG8_BAR;
            PG8_LDA(At, 1, 1); PG8_STAGE(PG8_SA(1, 0), a3, voffA);
            PG8_BAR; PG8_WAIT_L(0); PG8_MMA(1, 0, At, B0); PG8_BAR; PG8_SCHED;
            PG8_STAGE(PG8_SB(1, 1), b3 + hsB, voffB);
            PG8_WAIT_V(6); PG8_BAR; PG8_MMA(1, 1, At, B1); PG8_BAR;
            }
        }
        if constexpr (ALIGN_EPI) { if (wr == 0) PG8_BAR; }
        E(acc, cur, wr, wc, fr, fq);
        if (!has_next) break;
#pragma unroll
        for (int a = 0; a < 2; ++a)
#pragma unroll
            for (int b = 0; b < 2; ++b)
#pragma unroll
                for (int m = 0; m < 4; ++m)
#pragma unroll
                    for (int n = 0; n < 2; ++n) acc[a][b][m][n] = (f32x4){0.f, 0.f, 0.f, 0.f};
        cur = nxt; cA = nA; cB = nB; ++ui;
        if constexpr (ALIGN_EPI) { if (wr == 1) PG8_BAR; }
    }
    PG8_WAIT_V(0);
    if constexpr (!ALIGN_EPI) { if (wr == 0) PG8_BAR; }
    PG8_BAR;
#undef PG8_SA
#undef PG8_SB
#undef PG8_STAGE
#undef PG8_LDA
#undef PG8_LDB
#undef PG8_MMA
#undef PG8_WAIT_V
#undef PG8_WAIT_L
#undef PG8_BAR
#undef PG8_SCHED
#undef PG8_APTR
#undef PG8_BPTR
}
}
namespace attn_body {
using bf16=__hip_bfloat16;
using bf16x8=__attribute__((ext_vector_type(8)))short;
using s16x4=__attribute__((ext_vector_type(4)))short;
using f32x16=__attribute__((ext_vector_type(16)))float;
using u32x4=__attribute__((ext_vector_type(4)))unsigned;
constexpr int SEQ=16384,D=64,DM=1024;
constexpr int NW=8,QBLK=32,QB=QBLK*NW,KVBLK=64,NQB=SEQ/QB;
constexpr int ATTN_PITCH=DM, ATTN_UNIT_ROWS=QB;
__device__ __forceinline__ int crow(int r,int hi){return (r&3)+8*(r>>2)+4*hi;}
#define SBAR() __builtin_amdgcn_sched_barrier(0)
typedef __attribute__((address_space(3))) const int* lds_iptr;
__device__ __forceinline__ void cmask(f32x16&p0,f32x16&p1,lds_iptr ck,int qc,int hi){
  const float NEG=-INFINITY;
  #pragma unroll
  for(int r=0;r<16;++r){int kv=4*hi+(r&3)+8*(r>>2); if(ck[kv]>qc)p0[r]=NEG; if(ck[kv+32]>qc)p1[r]=NEG;}
}

constexpr int NSLOT=3, SLOTB=8192;
constexpr int LDS_K=0, LDS_V=NSLOT*SLOTB, LDS_WS=3*NSLOT*SLOTB  , LDS_OST=LDS_WS+NW*64*4, LDS_CID=LDS_OST+NW*4096, LDS_BYTES=LDS_CID+1024;
constexpr float C2=0.125f*1.4426950408889634f;
__device__ __forceinline__ void glds16(const void*gsrc,unsigned lds_dst){unsigned keep;
  asm volatile("s_mov_b32 %0, m0\n\ts_mov_b32 m0, %2\n\ts_nop 0\n\tglobal_load_lds_dwordx4 %1, off\n\ts_mov_b32 m0, %0":"=&s"(keep):"v"(gsrc),"s"(lds_dst):"memory");}
__device__ __forceinline__ float max3f(float a,float b,float c){float r;asm("v_max3_f32 %0, %1, %2, %3":"=v"(r):"v"(a),"v"(b),"v"(c));return r;}
__device__ __forceinline__ float max2f(float a,float b){float r;asm("v_max_f32_e32 %0, %1, %2":"=v"(r):"v"(a),"v"(b));return r;}
__device__ __forceinline__ float fadd_s(float a,float b){float r;asm("v_add_f32_e32 %0, %1, %2":"=v"(r):"v"(a),"v"(b));return r;}
__device__ __forceinline__ float fsub_s(float a,float b){float r;asm("v_sub_f32_e32 %0, %1, %2":"=v"(r):"v"(a),"v"(b));return r;}
typedef float f32x2_t __attribute__((ext_vector_type(2))); typedef __bf16 bf16x2_t __attribute__((ext_vector_type(2)));
__device__ __forceinline__ unsigned cvtpk_s(float lo,float hi){f32x2_t v={lo,hi};bf16x2_t b=__builtin_convertvector(v,bf16x2_t);return __builtin_bit_cast(unsigned,b);}
#define WAIT_BAR(N) asm volatile("s_waitcnt vmcnt(" #N ") lgkmcnt(0)\n\ts_barrier":::"memory")

__device__ __forceinline__ void qkt(f32x16&p0,f32x16&p1,const char*Kslot,const bf16x8*qr,int r32,int hi){ const f32x16 negm=f32x16{};
  const char*kb=Kslot+hi*1024+r32*16;
  #pragma unroll
  for(int d0=0;d0<4;++d0){
    const bf16x8 b0=*reinterpret_cast<const bf16x8*>(kb+d0*2048);
    const bf16x8 b1=*reinterpret_cast<const bf16x8*>(kb+d0*2048+512);
    if(d0==0){p0=__builtin_amdgcn_mfma_f32_32x32x16_bf16(b0,qr[0],negm,0,0,0);p1=__builtin_amdgcn_mfma_f32_32x32x16_bf16(b1,qr[0],negm,0,0,0);}
    else{p0=__builtin_amdgcn_mfma_f32_32x32x16_bf16(b0,qr[d0],p0,0,0,0);p1=__builtin_amdgcn_mfma_f32_32x32x16_bf16(b1,qr[d0],p1,0,0,0);}}
}
typedef __attribute__((address_space(3))) const char* lds_cptr;
typedef short v4i16_t __attribute__((ext_vector_type(4)));
__device__ __forceinline__ void kload8(bf16x8*kf,lds_cptr kp){
  kf[0]=*(const __attribute__((address_space(3))) bf16x8*)(kp);      kf[1]=*(const __attribute__((address_space(3))) bf16x8*)(kp+512);
  kf[2]=*(const __attribute__((address_space(3))) bf16x8*)(kp+2048); kf[3]=*(const __attribute__((address_space(3))) bf16x8*)(kp+2560);
  kf[4]=*(const __attribute__((address_space(3))) bf16x8*)(kp+4096); kf[5]=*(const __attribute__((address_space(3))) bf16x8*)(kp+4608);
  kf[6]=*(const __attribute__((address_space(3))) bf16x8*)(kp+6144); kf[7]=*(const __attribute__((address_space(3))) bf16x8*)(kp+6656);
}
__device__ __forceinline__ void kload2(bf16x8*kf,lds_cptr kp,int j){ kf[2*j]=*(const __attribute__((address_space(3))) bf16x8*)(kp+j*2048); kf[2*j+1]=*(const __attribute__((address_space(3))) bf16x8*)(kp+j*2048+512); }
__device__ __forceinline__ s16x4 vtr(lds_cptr p){ return __builtin_bit_cast(s16x4,__builtin_amdgcn_ds_read_tr16_b64_v4i16((__attribute__((address_space(3))) v4i16_t*)p)); }
__device__ __forceinline__ float rowmax(const f32x16&p0,const f32x16&p1){
  float a=max3f(p0[0],p0[1],p1[0]),b=max3f(p0[2],p0[3],p1[1]);a=max3f(a,p1[2],p1[3]);
  #pragma unroll
  for(int r=4;r<16;r+=4){a=max3f(a,p0[r],p0[r+1]);b=max3f(b,p0[r+2],p0[r+3]);a=max3f(a,p1[r],p1[r+1]);b=max3f(b,p1[r+2],p1[r+3]);}
  const float m=max2f(a,b);
  auto rr=__builtin_amdgcn_permlane32_swap(__float_as_uint(m),__float_as_uint(m),false,false);
  return max2f(__uint_as_float(rr[0]),__uint_as_float(rr[1]));
}
__device__ __forceinline__ void pv(f32x16*o,int vb,bf16x8 pa0,bf16x8 pa1,bf16x8 pa2,bf16x8 pa3){
  #pragma unroll
  for(int d0=0;d0<2;++d0){s16x4 lo[4],hi[4];
    #pragma unroll
    for(int ks=0;ks<4;++ks){
      asm volatile("ds_read_b64_tr_b16 %0,%1 offset:%c2":"=&v"(lo[ks]):"v"(vb),"i"(d0*4096+ks*1024):"memory");
      asm volatile("ds_read_b64_tr_b16 %0,%1 offset:%c2":"=&v"(hi[ks]):"v"(vb),"i"(d0*4096+ks*1024+512):"memory");}
    asm volatile("s_waitcnt lgkmcnt(0)":::"memory");SBAR();
    #define PK(k) (bf16x8){lo[k][0],lo[k][1],lo[k][2],lo[k][3],hi[k][0],hi[k][1],hi[k][2],hi[k][3]}
    o[d0]=__builtin_amdgcn_mfma_f32_32x32x16_bf16(pa0,PK(0),o[d0],0,0,0);
    o[d0]=__builtin_amdgcn_mfma_f32_32x32x16_bf16(pa1,PK(1),o[d0],0,0,0);
    o[d0]=__builtin_amdgcn_mfma_f32_32x32x16_bf16(pa2,PK(2),o[d0],0,0,0);
    o[d0]=__builtin_amdgcn_mfma_f32_32x32x16_bf16(pa3,PK(3),o[d0],0,0,0);
    #undef PK
  }
}

#ifndef ATTN_STORE16
#define ATTN_STORE16(p,v) (*(u32x4*)(p)=(v))
#endif
template<int THRL,bool FIXED> __device__ __forceinline__ void attn_unit(int qb,const bf16*Q,const bf16*__restrict__ Kh,const bf16*__restrict__ Vh,bf16*O,const int*__restrict__ cid,char*shm,const int wid){
  const int lane=lane_asm(),tid=wid*64+lane,r32=lane&31,hi=lane>>5;
  const int q0=qb*QB;
  const bf16*Qw=Q+(long)(q0+wid*QBLK)*DM;
  { __attribute__((address_space(3))) int* cw=(__attribute__((address_space(3))) int*)((__attribute__((address_space(3))) char*)shm+LDS_CID); if(tid<256)cw[tid]=cid[q0+tid]; }
  const lds_iptr cidl=(lds_iptr)((__attribute__((address_space(3))) const char*)shm+LDS_CID);
  const unsigned lds0=(unsigned)(uintptr_t)shm;
  float*wsf=(float*)(shm+LDS_WS)+wid*64;
  const bf16*ksrc=Kh+(long)lane*DM+wid*8;
  const bf16*vsrc=Vh+(long)(16*(wid&3)+(lane>>2))*DM+(wid>>2)*32+(lane&3)*8;
  const unsigned kdst=lds0+LDS_K+wid*1024, vdst=lds0+LDS_V+wid*1024;
  #define DMA_K(t,slot) glds16(ksrc+(long)(t)*KVBLK*DM,(unsigned)__builtin_amdgcn_readfirstlane(kdst+(slot)))
  #define DMA_V(t,slot) do{ glds16(vsrc+(long)(t)*KVBLK*DM,(unsigned)__builtin_amdgcn_readfirstlane(vdst+2*(slot))); glds16(vsrc+64+(long)(t)*KVBLK*DM,(unsigned)__builtin_amdgcn_readfirstlane(vdst+2*(slot)+8192)); }while(0)
  const int vb0=(int)(lds0+LDS_V)+((lane>>4)&1)*32+(lane&3)*8+(4*hi+((lane&15)>>2))*64;
  const char*Kbase=shm+LDS_K; bf16x8 kf[8];
  const lds_cptr shm3=(lds_cptr)shm; const lds_cptr kp0=shm3+LDS_K+hi*1024+r32*16; const lds_cptr vp0=shm3+LDS_V+((lane>>4)&1)*32+(lane&3)*8+(4*hi+((lane&15)>>2))*64;
  const int NT=(q0+QB)/KVBLK;
  DMA_K(0,0);DMA_V(0,0);DMA_K(1,SLOTB);
  bf16x8 qr[4];
  #pragma unroll
  for(int d0=0;d0<4;++d0)qr[d0]=*reinterpret_cast<const bf16x8*>(&Qw[(long)r32*DM+d0*16+hi*8]);
  float mhat=0.f,l_reg=0.f;f32x16 o[4];o[0]=f32x16{};o[1]=f32x16{};o[2]=f32x16{};o[3]=f32x16{};
  const int qrel=wid*QBLK+r32;
  #define CMASK(P0,P1,t) do{int jb_=(t)-(NT-4); if(jb_>=0)cmask(P0,P1,cidl+64*jb_,qc,hi);}while(0)
  bool resc=false;
  #define START(P0,P1) do{ resc=false; \
    if constexpr(!FIXED){ const float rm=rowmax(P0,P1); const float dl=rm; mhat=fadd_s(mhat,dl); \
      _Pragma("unroll") for(int r=0;r<16;++r){P0[r]=fsub_s(P0[r],dl);P1[r]=fsub_s(P1[r],dl);} \
      } \
    _Pragma("unroll") for(int r=0;r<16;++r)P0[r]=__builtin_amdgcn_exp2f(P0[r]); }while(0)
  #define RESC() do{ if constexpr(!FIXED) if(resc){ asm volatile("s_waitcnt lgkmcnt(0)":::"memory"); \
      _Pragma("unroll") for(int d_=0;d_<4;++d_) _Pragma("unroll") for(int r=0;r<16;++r)o[d_][r]*=wsf[crow(r,hi)]; } }while(0)
  f32x16 pA0,pA1,pB0,pB1;
  int sl_prev=0,sl_cur=0,sl_next=SLOTB;
  #define ROT() do{sl_prev=sl_cur;sl_cur=sl_next;sl_next=(sl_next==(NSLOT-1)*SLOTB)?0:sl_next+SLOTB;}while(0)
  DMA_K(2,2*SLOTB);
  WAIT_BAR(4);
  const int qc=cidl[qrel];
  qkt(pA0,pA1,Kbase,qr,r32,hi);asm volatile("s_nop 15\n\ts_nop 7":"+v"(pA0),"+v"(pA1));CMASK(pA0,pA1,0);
  START(pA0,pA1);
  _Pragma("unroll") for(int r=0;r<16;++r)pA1[r]=__builtin_amdgcn_exp2f(pA1[r]);
  WAIT_BAR(0);
  DMA_K(3,0);DMA_V(1,SLOTB);
  ROT();
  kload8(kf,kp0+sl_cur);
  WAIT_BAR(3);
  s16x4 vlo[8],vhi[8]; u32x4 pw0,pw1,pw2,pw3;
  #define PKW(P,B) cvtpk_s(P[B],P[B+1])
  #define PAF(k) __builtin_bit_cast(bf16x8,pw##k)
  #define VFR(i) (bf16x8){vlo[i][0],vlo[i][1],vlo[i][2],vlo[i][3],vhi[i][0],vhi[i][1],vhi[i][2],vhi[i][3]}
  #define PIN(x) asm volatile("":"+v"(x))
  #define MX3(a,b,c) __builtin_fmaxf(__builtin_fmaxf((a),(b)),(c))
  #define GAPA(MF,A0,A1,A2,A3,W0,W1,PW) do{ MF; sacc+=A0; sacc+=A1; sacc+=A2; sacc+=A3; PIN(sacc); W0; W1; PIN(PW); SBAR(); }while(0)
  #define EX(v) __builtin_amdgcn_exp2f(v)
  #define GAPB(MF,X,B) do{ MF; X[B]=EX(X[B]); X[B+1]=EX(X[B+1]); X[B+2]=EX(X[B+2]); X[B+3]=EX(X[B+3]); PIN(X); SBAR(); }while(0)
  #define VRD(i) do{ vlo[i]=vtr(vp_+(((i)>>2)*4096+((i)&3)*1024)); vhi[i]=vtr(vp_+(((i)>>2)*4096+((i)&3)*1024+512)); }while(0)
  #define VRD2(i) do{ vlo[i]=vtr(vp_+(8192+((i)>>2)*4096+((i)&3)*1024)); vhi[i]=vtr(vp_+(8192+((i)>>2)*4096+((i)&3)*1024+512)); SBAR(); }while(0)
  #define GAPB2(MF,X,B) do{ MF; if constexpr(FIXED){ X[B]=EX(X[B]); X[B+1]=EX(X[B+1]); } else { X[B]=EX(X[B]-mhat); X[B+1]=EX(X[B+1]-mhat); } PIN(X); SBAR(); }while(0)
  #define KRD(G,j) do{ if(G){ kload2(kf,kp0+sl_next,j); SBAR(); } }while(0)
  #define STEP(C0,C1,P0,P1,t,GK,GV,GL) do{ SBAR(); \
    const lds_cptr vp_=vp0+2*sl_prev; \
    VRD(0); SBAR(); float sacc=(P0[0]+P0[1]); \
    GAPA(C0=__builtin_amdgcn_mfma_f32_32x32x16_bf16(kf[0],qr[0],f32x16{},0,0,0), P0[2],P0[3],P0[4],P0[5],     pw0[0]=PKW(P0,0), pw0[1]=PKW(P0,2), pw0); \
    VRD(4); SBAR(); GAPA(C1=__builtin_amdgcn_mfma_f32_32x32x16_bf16(kf[1],qr[0],f32x16{},0,0,0), P0[6],P0[7],P0[8],P0[9],     pw0[2]=PKW(P0,4), pw0[3]=PKW(P0,6), pw0); \
    VRD(1); SBAR(); GAPA(C0=__builtin_amdgcn_mfma_f32_32x32x16_bf16(kf[2],qr[1],C0,0,0,0),   P0[10],P0[11],P0[12],P0[13], pw1[0]=PKW(P0,8), pw1[1]=PKW(P0,10), pw1); \
    VRD(5); SBAR(); GAPA(C1=__builtin_amdgcn_mfma_f32_32x32x16_bf16(kf[3],qr[1],C1,0,0,0),   P0[14],P0[15],P1[0],P1[1],   pw1[2]=PKW(P0,12),pw1[3]=PKW(P0,14), pw1); \
    VRD(2); SBAR(); GAPA(C0=__builtin_amdgcn_mfma_f32_32x32x16_bf16(kf[4],qr[2],C0,0,0,0),   P1[2],P1[3],P1[4],P1[5],     pw2[0]=PKW(P1,0), pw2[1]=PKW(P1,2), pw2); \
    VRD(6); SBAR(); GAPA(C1=__builtin_amdgcn_mfma_f32_32x32x16_bf16(kf[5],qr[2],C1,0,0,0),   P1[6],P1[7],P1[8],P1[9],     pw2[2]=PKW(P1,4), pw2[3]=PKW(P1,6), pw2); \
    VRD(3); SBAR(); GAPA(C0=__builtin_amdgcn_mfma_f32_32x32x16_bf16(kf[6],qr[3],C0,0,0,0),   P1[10],P1[11],P1[12],P1[13], pw3[0]=PKW(P1,8), pw3[1]=PKW(P1,10), pw3); \
    VRD(7); SBAR(); GAPA(C1=__builtin_amdgcn_mfma_f32_32x32x16_bf16(kf[7],qr[3],C1,0,0,0),   P1[14],P1[15],0.f,0.f,       pw3[2]=PKW(P1,12),pw3[3]=PKW(P1,14), pw3); \
    l_reg+=sacc; \
    if(GK){DMA_K((t)+3,sl_cur);} if(GV){DMA_V((t)+1,sl_next);} \
    CMASK(C0,C1,t); \
    if constexpr(!FIXED){ float a=MX3(C0[0],C0[1],C1[0]),b=MX3(C0[2],C0[3],C1[1]); a=MX3(a,C1[2],C1[3]); \
      _Pragma("unroll") for(int r=4;r<16;r+=4){a=MX3(a,C0[r],C0[r+1]);b=MX3(b,C0[r+2],C0[r+3]);a=MX3(a,C1[r],C1[r+1]);b=MX3(b,C1[r+2],C1[r+3]);} \
      float rm=__builtin_fmaxf(a,b); { auto rr=__builtin_amdgcn_permlane32_swap(__float_as_uint(rm),__float_as_uint(rm),false,false); rm=__builtin_fmaxf(__uint_as_float(rr[0]),__uint_as_float(rr[1])); } \
      rm-=mhat; resc=false; \
      if(__builtin_expect(__any(rm>(float)THRL),0)){ const float dl=__builtin_fmaxf(rm,0.f); mhat+=dl; \
        const float f=__builtin_amdgcn_exp2f(-dl); l_reg*=f; if(hi==0)wsf[r32]=f; resc=true; } \
      } \
    SBAR(); \
    GAPB2(o[0]=__builtin_amdgcn_mfma_f32_32x32x16_bf16(PAF(0),VFR(0),o[0],0,0,0), C0,0); VRD2(0); \
    GAPB2(o[1]=__builtin_amdgcn_mfma_f32_32x32x16_bf16(PAF(0),VFR(4),o[1],0,0,0), C0,2); VRD2(4); \
    KRD(GL,0); GAPB2(o[0]=__builtin_amdgcn_mfma_f32_32x32x16_bf16(PAF(1),VFR(1),o[0],0,0,0), C0,4); VRD2(1); \
    KRD(GL,1); GAPB2(o[1]=__builtin_amdgcn_mfma_f32_32x32x16_bf16(PAF(1),VFR(5),o[1],0,0,0), C0,6); VRD2(5); \
    KRD(GL,2); GAPB2(o[0]=__builtin_amdgcn_mfma_f32_32x32x16_bf16(PAF(2),VFR(2),o[0],0,0,0), C0,8); VRD2(2); \
    KRD(GL,3); GAPB2(o[1]=__builtin_amdgcn_mfma_f32_32x32x16_bf16(PAF(2),VFR(6),o[1],0,0,0), C0,10); VRD2(6); \
    GAPB2(o[0]=__builtin_amdgcn_mfma_f32_32x32x16_bf16(PAF(3),VFR(3),o[0],0,0,0), C0,12); VRD2(3); \
    GAPB2(o[1]=__builtin_amdgcn_mfma_f32_32x32x16_bf16(PAF(3),VFR(7),o[1],0,0,0), C0,14); VRD2(7); \
    GAPB2(o[2]=__builtin_amdgcn_mfma_f32_32x32x16_bf16(PAF(0),VFR(0),o[2],0,0,0), C1,0); \
    GAPB2(o[3]=__builtin_amdgcn_mfma_f32_32x32x16_bf16(PAF(0),VFR(4),o[3],0,0,0), C1,2); \
    GAPB2(o[2]=__builtin_amdgcn_mfma_f32_32x32x16_bf16(PAF(1),VFR(1),o[2],0,0,0), C1,4); \
    GAPB2(o[3]=__builtin_amdgcn_mfma_f32_32x32x16_bf16(PAF(1),VFR(5),o[3],0,0,0), C1,6); \
    GAPB2(o[2]=__builtin_amdgcn_mfma_f32_32x32x16_bf16(PAF(2),VFR(2),o[2],0,0,0), C1,8); \
    GAPB2(o[3]=__builtin_amdgcn_mfma_f32_32x32x16_bf16(PAF(2),VFR(6),o[3],0,0,0), C1,10); \
    GAPB2(o[2]=__builtin_amdgcn_mfma_f32_32x32x16_bf16(PAF(3),VFR(3),o[2],0,0,0), C1,12); \
    GAPB2(o[3]=__builtin_amdgcn_mfma_f32_32x32x16_bf16(PAF(3),VFR(7),o[3],0,0,0), C1,14); \
    }while(0)
  int t=1;
  #undef CMASK
  #define CMASK(P0,P1,t) do{}while(0)
  for(;t+5<NT;t+=2){
    STEP(pB0,pB1,pA0,pA1,t,true,true,true);     WAIT_BAR(3); RESC(); ROT();
    STEP(pA0,pA1,pB0,pB1,t+1,true,true,true);   WAIT_BAR(3); RESC(); ROT();
  }
  #undef CMASK
  #define CMASK(P0,P1,t) do{int jb_=(t)-(NT-4); if(jb_>=0)cmask(P0,P1,cidl+64*jb_,qc,hi);}while(0)
  #define ENDW(tt) do{ if((tt)+3<NT){WAIT_BAR(3);} else if((tt)+2<NT){WAIT_BAR(2);} else {WAIT_BAR(0);} }while(0)
  for(;t+1<NT;t+=2){
    STEP(pB0,pB1,pA0,pA1,t,(t+3<NT),(t+1<NT),(t+1<NT));       ENDW(t);   RESC(); ROT();
    STEP(pA0,pA1,pB0,pB1,t+1,(t+4<NT),(t+2<NT),(t+2<NT));     ENDW(t+1); RESC(); ROT();
  }
  STEP(pB0,pB1,pA0,pA1,NT-1,false,false,false); RESC();
  { float sacc=pB0[0]+pB0[1]; _Pragma("unroll") for(int r=2;r<16;++r)sacc+=pB0[r]; _Pragma("unroll") for(int r=0;r<16;++r)sacc+=pB1[r]; l_reg+=sacc;
    pw0=(u32x4){PKW(pB0,0),PKW(pB0,2),PKW(pB0,4),PKW(pB0,6)};pw1=(u32x4){PKW(pB0,8),PKW(pB0,10),PKW(pB0,12),PKW(pB0,14)};pw2=(u32x4){PKW(pB1,0),PKW(pB1,2),PKW(pB1,4),PKW(pB1,6)};pw3=(u32x4){PKW(pB1,8),PKW(pB1,10),PKW(pB1,12),PKW(pB1,14)};
    SBAR(); pv(o,vb0+2*sl_cur,PAF(0),PAF(1),PAF(2),PAF(3)); pv(o+2,vb0+2*sl_cur+8192,PAF(0),PAF(1),PAF(2),PAF(3)); }
  #undef PKW
  #undef PAF
  #undef VFR
  #undef PIN
  #undef MX3
  #undef GAPA
  #undef GAPB
  #undef EX
  #undef VRD
  #undef VRD2
  #undef GAPB2
  #undef KRD
  #undef STEP
  #undef ENDW
  {auto rr=__builtin_amdgcn_permlane32_swap(__float_as_uint(l_reg),__float_as_uint(l_reg),false,false);l_reg=__uint_as_float(rr[0])+__uint_as_float(rr[1]);}
  if(hi==0)wsf[32+r32]=l_reg;asm volatile("s_waitcnt lgkmcnt(0)":::"memory");
  float rli[16];
  #pragma unroll
  for(int r=0;r<16;++r)rli[r]=__builtin_amdgcn_rcpf(wsf[32+crow(r,hi)]);
  bf16*Ow=O+(long)(q0+wid*QBLK)*DM;
  { bf16*stg=(bf16*)(shm+LDS_OST)+wid*2048;
    #pragma unroll
    for(int e=0;e<2;++e){
      #pragma unroll
      for(int r=0;r<16;++r){const int orow=crow(r,hi);
        #pragma unroll
        for(int d0=0;d0<2;++d0)stg[orow*64+d0*32+r32]=__float2bfloat16(o[2*e+d0][r]*rli[r]);}
      asm volatile("s_waitcnt lgkmcnt(0)":::"memory");
      #pragma unroll
      for(int i=0;i<4;++i){const int row=i*8+(lane>>3),ch=lane&7; const u32x4 v=*(const u32x4*)(stg+row*64+ch*8); ATTN_STORE16(Ow+(long)row*DM+e*64+ch*8,v);}
      asm volatile("s_waitcnt lgkmcnt(0)":::"memory"); } }
  asm volatile("s_waitcnt lgkmcnt(0)\n\ts_barrier":::"memory");
  #undef DMA_K
  #undef DMA_V
  #undef CMASK
  #undef START
  #undef RESC
  #undef ROT
}
constexpr int ATTN_LDS_BYTES=LDS_BYTES;
struct AttnTensors { const bf16* Q; const bf16* K; const bf16* V; bf16* O; const int* cid; const float* qn; const float* kn; };
struct AttnUnit { int bh; int qb; };
struct StaticOrder {
  int vcu,G;
  __device__ __forceinline__ explicit StaticOrder(int grid,int block):vcu((grid%8==0)?(block%8)*(grid/8)+block/8:block),G(grid){}
  __device__ __forceinline__ bool next(int i,AttnUnit&u)const{ const int v=vcu+(i>>2)*G; if(v>=256)return false; const int s=v&15,k=i&3; u.bh=v>>4; u.qb=(k&1)?(32*(k>>1)+31-s):(32*(k>>1)+s); return true; }
};
template<class Sched,int THRL=8> __device__ __forceinline__ void attn_phase(char*lds,const AttnTensors&T,const Sched&S,const int wid){
  bool fixed; { const int l=lane_asm(); float gq=__builtin_fabsf(T.qn[l]),gk=__builtin_fabsf(T.kn[l]);
    #pragma unroll
    for(int o_=1;o_<64;o_<<=1){gq=__builtin_fmaxf(gq,__shfl_xor(gq,o_));gk=__builtin_fmaxf(gk,__shfl_xor(gk,o_));}
    const float bound=C2*64.0f*1.03f*gq*gk; fixed=__builtin_amdgcn_readfirstlane((int)(bound<=60.0f))!=0; }
  AttnUnit u;
  for(int i=0;S.next(i,u);++i){ const int h=u.bh>>1,c=u.bh&1;
    if(fixed) attn_unit<THRL,true>(u.qb,T.Q+u.bh*64,T.K+u.bh*64,T.V+h*128,T.O+(long)c*SEQ*DM+h*128,T.cid,lds,wid);
    else attn_unit<THRL,false>(u.qb,T.Q+u.bh*64,T.K+u.bh*64,T.V+h*128,T.O+(long)c*SEQ*DM+h*128,T.cid,lds,wid); }
}
#undef SBAR
#undef WAIT_BAR
}
#define GAS __attribute__((address_space(1)))
#define LAS __attribute__((address_space(3)))
typedef unsigned short bf16;
typedef unsigned v4u __attribute__((ext_vector_type(4)));
typedef unsigned v2u __attribute__((ext_vector_type(2)));
typedef float f32x4 __attribute__((ext_vector_type(4)));
#define LDS_WAIT() asm volatile("s_waitcnt lgkmcnt(0)" ::: "memory")

constexpr int NWAVES = 8, NTHR = 512;
constexpr int M = 16384, DMODEL = 2048, FF = 5632, NUP = 2 * FF, NIN = 4096, NMOD = 9 * DMODEL;
constexpr int NPH = 16;
#ifndef MK_N_LAUNCHES
#define MK_N_LAUNCHES 1
#endif
constexpr size_t MiB = 1u << 20;
constexpr size_t WS_MODP = 1 * MiB, WS_MOD = 4 * MiB, WS_CID = 4 * MiB + 512 * 1024, WS_A16 = 5 * MiB, WS_CS = 6 * MiB, WS_SSQ = 7 * MiB, WS_BV = 8 * MiB, WS_GM = 9 * MiB;
constexpr size_t WS_W1U = 16 * MiB, WS_W1D = 60 * MiB, WS_W2U = 82 * MiB, WS_W2D = 126 * MiB, WS_WIN = 148 * MiB, WS_WOUT = 164 * MiB, WS_WGLU = 172 * MiB, WS_BE = 174 * MiB, WS_BY = 186 * MiB;
constexpr size_t WS_HB = 198 * MiB, WS_H = 262 * MiB, WS_Q = 262 * MiB, WS_K = 294 * MiB, WS_V = 326 * MiB, WS_UGS = 358 * MiB, WS_E = 406 * MiB, WS_END = 438 * MiB;
constexpr size_t WS_O32 = WS_HB, WS_YG = WS_E, WS_Y2 = WS_Q, WS_MIX = WS_K;
static_assert(WS_H + (size_t)M * FF * 2 <= WS_END && WS_UGS + (size_t)1024 * 64 * 384 * 2 <= WS_E && WS_E + (size_t)1024 * 8192 * 4 <= WS_END, "ws map");
constexpr int LDS_BYTES = 147456;

__device__ __forceinline__ unsigned f2bf(float f) { unsigned u = __builtin_bit_cast(unsigned, f); return (u + 0x7fffu + ((u >> 16) & 1u)) >> 16; }
__device__ __forceinline__ unsigned pk2(float lo, float hi) { return f2bf(lo) | (f2bf(hi) << 16); }
__device__ __forceinline__ float blo(unsigned w) { return __uint_as_float(w << 16); }
__device__ __forceinline__ float bhi(unsigned w) { return __uint_as_float(w & 0xffff0000u); }
__device__ __forceinline__ float wave_sum(float v) {
#pragma unroll
    for (int o = 1; o < 64; o <<= 1) v += __shfl_xor(v, o);
    return v;
}
__device__ __forceinline__ void unpack16(const bf16* p, float (&v)[16]) {
    const v4u a = *(const v4u*)p, b = *(const v4u*)(p + 8);
    v[0] = blo(a.x); v[1] = bhi(a.x); v[2] = blo(a.y); v[3] = bhi(a.y); v[4] = blo(a.z); v[5] = bhi(a.z); v[6] = blo(a.w); v[7] = bhi(a.w);
    v[8] = blo(b.x); v[9] = bhi(b.x); v[10] = blo(b.y); v[11] = bhi(b.y); v[12] = blo(b.z); v[13] = bhi(b.z); v[14] = blo(b.w); v[15] = bhi(b.w);
}
__device__ __forceinline__ void pack16(bf16* p, const float (&v)[16]) {
    v4u a, b; a.x = pk2(v[0], v[1]); a.y = pk2(v[2], v[3]); a.z = pk2(v[4], v[5]); a.w = pk2(v[6], v[7]);
    b.x = pk2(v[8], v[9]); b.y = pk2(v[10], v[11]); b.z = pk2(v[12], v[13]); b.w = pk2(v[14], v[15]);
    *(v4u*)p = a; *(v4u*)(p + 8) = b;
}

__device__ __forceinline__ void p0_transpose_item(const float* W, int K, int N, bf16* WT, int mode, LAS float* scr, int item, int lane) {
    const int nblk = N / 32, kb = item / nblk, nb = item % nblk, k0 = 64 * kb, n0 = 32 * nb;
#pragma unroll 8
    for (int i = 0; i < 32; ++i) { const int kk = 2 * i + (lane >> 5); scr[kk * 33 + (lane & 31)] = W[(size_t)(k0 + kk) * N + n0 + (lane & 31)]; }
    LDS_WAIT(); asm volatile("" ::: "memory");
    const int c = lane & 7;
#pragma unroll
    for (int j = 0; j < 4; ++j) { const int n = (lane >> 3) + 8 * j; const LAS float* s = scr + (8 * c) * 33 + n;
        v4u o; o.x = pk2(s[0 * 33], s[1 * 33]); o.y = pk2(s[2 * 33], s[3 * 33]); o.z = pk2(s[4 * 33], s[5 * 33]); o.w = pk2(s[6 * 33], s[7 * 33]);
        const int nn = n0 + n; const int drow = mode == 0 ? nn : ((nn >> 7) * 256 + (mode == 2 ? 128 : 0) + (nn & 127));
        *(v4u*)(WT + (size_t)drow * K + k0 + 8 * c) = o; }
    LDS_WAIT(); asm volatile("" ::: "memory");
}
struct TrItem { const float* W; bf16* WT; int K, N, mode, item; };
__device__ __forceinline__ void tr_load(const TrItem& t, int lane, f32x4 (&r)[8]) {
    const int nblk = t.N / 32, kb = t.item / nblk, nb = t.item % nblk;
    const float* p = t.W + (size_t)(64 * kb + (lane >> 3)) * t.N + 32 * nb + (lane & 7) * 4;
#pragma unroll
    for (int i = 0; i < 8; ++i) r[i] = *(const f32x4*)(p + (size_t)(8 * i) * t.N);
}
__device__ __forceinline__ void tr_store(const TrItem& t, int lane, const f32x4 (&r)[8], LAS float* scr) {
    const int nblk = t.N / 32, kb = t.item / nblk, nb = t.item % nblk, k0 = 64 * kb, n0 = 32 * nb;
#pragma unroll
    for (int i = 0; i < 8; ++i) { LAS float* d = scr + (8 * i + (lane >> 3)) * 33 + (lane & 7) * 4; d[0] = r[i].x; d[1] = r[i].y; d[2] = r[i].z; d[3] = r[i].w; }
    LDS_WAIT(); asm volatile("" ::: "memory");
    const int c = lane & 7;
#pragma unroll
    for (int j = 0; j < 4; ++j) { const int n = (lane >> 3) + 8 * j; const LAS float* s = scr + (8 * c) * 33 + n;
        v4u o; o.x = pk2(s[0 * 33], s[1 * 33]); o.y = pk2(s[2 * 33], s[3 * 33]); o.z = pk2(s[4 * 33], s[5 * 33]); o.w = pk2(s[6 * 33], s[7 * 33]);
        const int nn = n0 + n; int drow = t.mode == 0 ? nn : ((nn >> 7) * 256 + (t.mode == 2 ? 128 : 0) + (nn & 127));
        if (t.mode == 3) drow = nn < 2048 ? ((nn >> 8) * 256 + ((nn >> 5) & 1) * 128 + ((nn >> 6) & 3) * 32 + (nn & 31)) : nn;
        *(v4u*)(t.WT + (size_t)drow * t.K + k0 + 8 * c) = o; }
    LDS_WAIT(); asm volatile("" ::: "memory");
}
__device__ __forceinline__ void norm_load2(const float* X, int r0, int r1, int lane, f32x4 (&v)[2][8]) {
    const f32x4* x0 = (const f32x4*)(X + (size_t)(r0 < M ? r0 : 0) * DMODEL) + lane; const f32x4* x1 = (const f32x4*)(X + (size_t)(r1 < M ? r1 : 0) * DMODEL) + lane;
#pragma unroll
    for (int j = 0; j < 8; ++j) { v[0][j] = x0[64 * j]; v[1][j] = x1[64 * j]; }
}
__device__ __forceinline__ void norm_store2(bf16* O, int r0, int r1, int lane, const f32x4 (&v)[2][8], const f32x4 (&gm)[8], const f32x4 (&hs)[8]) {
#pragma unroll
    for (int q = 0; q < 2; ++q) { const int r = q == 0 ? r0 : r1; float s = 0.f;
#pragma unroll
        for (int j = 0; j < 8; ++j) s += (v[q][j].x * v[q][j].x + v[q][j].y * v[q][j].y) + (v[q][j].z * v[q][j].z + v[q][j].w * v[q][j].w);
        const float rstd = 1.0f / sqrtf(wave_sum(s) * (1.0f / DMODEL) + 1e-6f);
        if (r < M) { bf16* orow = O + (size_t)r * DMODEL;
#pragma unroll
            for (int j = 0; j < 8; ++j) { const f32x4 y = (v[q][j] * rstd) * gm[j] + hs[j]; v2u o; o.x = pk2(y.x, y.y); o.y = pk2(y.z, y.w); *(v2u*)(orow + 4 * (lane + 64 * j)) = o; } } }
}
__device__ __forceinline__ void norm_mod_pass(const float* X, const float* gam, const float* sc, const float* sh, bf16* O, int gw, int NGW, int lane) {
    f32x4 va[2][8], vb[2][8];
    norm_load2(X, gw, gw + NGW, lane, va);
    f32x4 gm[8], hs[8];
#pragma unroll
    for (int j = 0; j < 8; ++j) { const int col = 4 * (lane + 64 * j); gm[j] = *(const f32x4*)(gam + col) * (*(const f32x4*)(sc + col) + 1.0f); hs[j] = *(const f32x4*)(sh + col); }
    for (int row = gw; row < M; row += 4 * NGW) {
        norm_load2(X, row + 2 * NGW, row + 3 * NGW, lane, vb);
        norm_store2(O, row, row + NGW, lane, va, gm, hs);
        norm_load2(X, row + 4 * NGW, row + 5 * NGW, lane, va);
        norm_store2(O, row + 2 * NGW, row + 3 * NGW, lane, vb, gm, hs);
    }
}
__device__ __forceinline__ void norm_mod_row(const float* xrow, const float* gam, const float* sc, const float* sh, bf16* orow, int lane) {
    const f32x4* xr = (const f32x4*)xrow + lane;
    f32x4 v[8]; float s = 0.f;
#pragma unroll
    for (int j = 0; j < 8; ++j) { v[j] = xr[64 * j]; s += (v[j].x * v[j].x + v[j].y * v[j].y) + (v[j].z * v[j].z + v[j].w * v[j].w); }
    const float rstd = 1.0f / sqrtf(wave_sum(s) * (1.0f / DMODEL) + 1e-6f);
#pragma unroll
    for (int j = 0; j < 8; ++j) { const int col = 4 * (lane + 64 * j);
        const f32x4 g4 = *(const f32x4*)(gam + col), c4 = *(const f32x4*)(sc + col), h4 = *(const f32x4*)(sh + col);
        const f32x4 y = (v[j] * rstd * g4) * (c4 + 1.0f) + h4;
        v2u o; o.x = pk2(y.x, y.y); o.y = pk2(y.z, y.w); *(v2u*)(orow + col) = o; }
}
__device__ __forceinline__ void ssm_gen(int g, LAS float* S, const float* a_re, const float* a_im, const float* log_dt, const float* b_re, const float* b_im,
                                        const float* c_re, const float* c_im, bf16* BY, bf16* BE, float* A16, int tid) {
    LAS float* ljr = S; LAS float* lji = S + 17 * 64;
    LAS float* bbr = S + 2 * 17 * 64; LAS float* bbi = bbr + 1024;
    LAS float* ccr = bbi + 1024; LAS float* cci = ccr + 1024;
    LAS float* km = cci + 1024;
    const float dt = expf(log_dt[g]);
    for (int idx = tid; idx < 17 * 64; idx += NTHR) { const int j = idx >> 6, p = idx & 63;
        const float re = fminf(a_re[g * 64 + p], -1e-4f), im = a_im[g * 64 + p];
        const float mag = expf((float)j * re * dt), ang = (float)j * im * dt;
        ljr[idx] = mag * cosf(ang); lji[idx] = mag * sinf(ang); }
    for (int idx = tid; idx < 1024; idx += NTHR) { const int p = idx >> 4;
        const float re = fminf(a_re[g * 64 + p], -1e-4f), im = a_im[g * 64 + p];
        const float mag = expf(re * dt), ang = im * dt; const float xr = mag * cosf(ang) - 1.0f, xi = mag * sinf(ang);
        const float den = 1.0f / (re * re + im * im); const float qr = (xr * re + xi * im) * den, qi = (xi * re - xr * im) * den;
        const float br = b_re[(size_t)g * 1024 + idx], bi = b_im[(size_t)g * 1024 + idx];
        bbr[idx] = qr * br - qi * bi; bbi[idx] = qr * bi + qi * br;
        ccr[idx] = c_re[(size_t)g * 1024 + idx]; cci[idx] = c_im[(size_t)g * 1024 + idx]; }
    __syncthreads();
    if (tid < 64) { A16[(g * 64 + tid) * 2] = ljr[16 * 64 + tid]; A16[(g * 64 + tid) * 2 + 1] = lji[16 * 64 + tid]; }
    for (int idx = tid; idx < 4096; idx += NTHR) { const int j = idx >> 8, co = (idx >> 4) & 15, ci = idx & 15; float s = 0.f;
        for (int p = 0; p < 64; ++p) { const float cr = ccr[co * 64 + p], cim = cci[co * 64 + p], lr = ljr[j * 64 + p], li = lji[j * 64 + p];
            const float tr = cr * lr - cim * li, ti = cr * li + cim * lr; s += tr * bbr[p * 16 + ci] - ti * bbi[p * 16 + ci]; }
        km[idx] = s; }
    __syncthreads();
    unsigned* BYg = (unsigned*)(BY + (size_t)g * 256 * 384);
    for (int i2 = tid; i2 < 256 * 192; i2 += NTHR) { const int row = i2 / 192, col = (i2 % 192) * 2, tl = row >> 4, co = row & 15; float v[2];
#pragma unroll
        for (int e = 0; e < 2; ++e) { const int cc = col + e;
            if (cc < 256) { const int sl = cc >> 4, ci = cc & 15; v[e] = (tl >= sl) ? km[(tl - sl) * 256 + co * 16 + ci] : 0.f; }
            else { const int q = cc - 256, p = q & 63; const float cr = ccr[co * 64 + p], cim = cci[co * 64 + p], lr = ljr[(tl + 1) * 64 + p], li = lji[(tl + 1) * 64 + p];
                v[e] = (q < 64) ? (cr * lr - cim * li) : -(cr * li + cim * lr); } }
        BYg[i2] = pk2(v[0], v[1]); }
    const int gi = g & 1; unsigned* BEg = (unsigned*)(BE + ((size_t)(g >> 1) * 256 + gi * 128) * 768);
    for (int i2 = tid; i2 < 128 * 384; i2 += NTHR) { const int r = i2 / 384, col = (i2 % 384) * 2, part = r >> 6, p = r & 63; float v[2];
#pragma unroll
        for (int e = 0; e < 2; ++e) { const int c2 = col + e, gj = c2 >= 384 ? 1 : 0, cc = c2 - gj * 384;
            if (gj == gi && cc < 256) { const int sl = cc >> 4, ci = cc & 15; const float lr = ljr[(15 - sl) * 64 + p], li = lji[(15 - sl) * 64 + p], br = bbr[p * 16 + ci], bi = bbi[p * 16 + ci];
                v[e] = part == 0 ? (lr * br - li * bi) : (lr * bi + li * br); }
            else v[e] = 0.f; }
        BEg[i2] = pk2(v[0], v[1]); }
    __syncthreads();
}


#define XB_TMO      128
#define XB_XCNT(j)  (256  + 64 * (j))
#define XB_XSUB(j)  (1280 + 64 * (j))
#define XB_XGEN(j)  (2304 + 64 * (j))
#define XB_TOP      3328
#define XB_TOPGEN   3392
#define XCD_BAR_WORDS 3456
#define XB_SPIN_CAP (1u << 22)
__device__ __forceinline__ unsigned xb_ld(unsigned* p)              { return __hip_atomic_load(p, __ATOMIC_RELAXED, __HIP_MEMORY_SCOPE_AGENT); }
__device__ __forceinline__ unsigned xb_add(unsigned* p, unsigned v) { return __hip_atomic_fetch_add(p, v, __ATOMIC_RELAXED, __HIP_MEMORY_SCOPE_AGENT); }
__device__ __forceinline__ unsigned xb_xcc_id() { return (unsigned)__builtin_amdgcn_s_getreg((3 << 11) | 20) & 0xFu; }
#define XB_SPIN(cond, bar) do { unsigned _sp = 0; while (cond) { __builtin_amdgcn_s_sleep(1); \
    if ((++_sp & 255u) == 0u) { if (xb_ld(&(bar)[XB_TMO])) break; if (_sp > XB_SPIN_CAP) { atomicAdd(&(bar)[XB_TMO], 1u); break; } } } } while (0)
__device__ __forceinline__ void xcd_barrier_complete(unsigned* bar, unsigned x, unsigned& nloc, unsigned& nx) {
    const unsigned G = gridDim.x * gridDim.y * gridDim.z;
    unsigned sum, cnt, mine, sp = 0u;
    for (;;) {
        sum = 0u; cnt = 0u; mine = 0u;
#pragma unroll
        for (unsigned j = 0; j < 16; ++j) { const unsigned c = xb_ld(&bar[XB_XCNT(j)]); sum += c; cnt += (c > 0u) ? 1u : 0u; mine = (j == x) ? c : mine; }
        if (sum == G) break;
        __builtin_amdgcn_s_sleep(1);
        if ((++sp & 255u) == 0u) { if (xb_ld(&bar[XB_TMO])) break; if (sp > XB_SPIN_CAP) { atomicAdd(&bar[XB_TMO], 1u); break; } }
    }
    nloc = mine > 0u ? mine : 1u; nx = cnt > 0u ? cnt : 1u;
}
__device__ __forceinline__ void xcd_barrier(unsigned* bar, volatile LAS unsigned* st, bool lead) {
    asm volatile("s_waitcnt vmcnt(0)" ::: "memory");
    __syncthreads();
    if (lead) {
        __builtin_amdgcn_s_waitcnt(0);
        const unsigned x = xb_xcc_id();
        unsigned nloc = st[0], nx = st[1];
        if (nloc == 0u) { xcd_barrier_complete(bar, x, nloc, nx); st[0] = nloc; st[1] = nx; }
        const unsigned old = xb_add(&bar[XB_XSUB(x)], 1u);
        const unsigned gen = old / nloc;
        if (old + 1u == (gen + 1u) * nloc) {
            __builtin_amdgcn_fence(__ATOMIC_RELEASE, "agent");
            asm volatile("s_waitcnt vmcnt(0)" ::: "memory");
            const unsigned og = xb_add(&bar[XB_TOP], 1u);
            const unsigned tg = og / nx;
            if (og + 1u == (tg + 1u) * nx) xb_add(&bar[XB_TOPGEN], 1u);
            else XB_SPIN(xb_ld(&bar[XB_TOPGEN]) == tg, bar);
            __builtin_amdgcn_fence(__ATOMIC_ACQUIRE, "agent");
            xb_add(&bar[XB_XGEN(x)], 1u);
            asm volatile("s_waitcnt vmcnt(0)" ::: "memory");
        } else {
            XB_SPIN(xb_ld(&bar[XB_XGEN(x)]) == gen, bar);
            __builtin_amdgcn_fence(__ATOMIC_ACQUIRE, "agent");
            asm volatile("s_waitcnt vmcnt(0)" ::: "memory");
        }
    }
    __syncthreads();
}
constexpr int TAB_OFF = 131072;
__device__ __forceinline__ const void* ldptr(LAS unsigned char* L, int k) {
    const LAS unsigned* t = (const LAS unsigned*)(L + TAB_OFF) + 2 * k;
    const unsigned lo = __builtin_amdgcn_readfirstlane(t[0]), hi = __builtin_amdgcn_readfirstlane(t[1]);
    return (const void*)(((unsigned long long)hi << 32) | lo);
}
struct Args { const void* in[34]; float* out; unsigned char* ws; int ph_lo, ph_hi; };
static_assert(sizeof(Args) == 34 * 8 + 8 + 8 + 8, "Args has no padding");

__global__ void __launch_bounds__(NTHR, 2) mk_fwd(Args args) {
    extern __shared__ __attribute__((aligned(16))) unsigned char lds[];
    LAS unsigned char* L = (LAS unsigned char*)lds;
    const int wave = __builtin_amdgcn_readfirstlane((int)threadIdx.x >> 6);
    const int G = gridDim.x, bx = blockIdx.x;
    const int gw = bx * NWAVES + wave, NGW = G * NWAVES;
    cg::grid_group grid = cg::this_grid();
    const int lo = args.ph_lo, hi = args.ph_hi;
#ifndef PHMASK
#define PHMASK 0xffff
#endif
#define IN(k) (((PHMASK >> (k)) & 1) && lo <= (k) && (k) < hi)
#define SEAM(k) do { if (IN(k) && IN((k) + 1)) xcd_barrier((unsigned*)p_ws, (volatile LAS unsigned*)(L + TAB_OFF + 512), wave == 0 && lane_asm() == 0); } while (0)
    if (threadIdx.x == 0) { LAS unsigned long long* tb = (LAS unsigned long long*)(L + TAB_OFF);
#pragma unroll
        for (int i = 0; i < 34; ++i) tb[i] = (unsigned long long)args.in[i];
        tb[34] = (unsigned long long)args.out; tb[35] = (unsigned long long)args.ws; ((LAS unsigned*)(L + TAB_OFF + 512))[0] = 0u; ((LAS unsigned*)(L + TAB_OFF + 512))[1] = 0u; }
    __syncthreads();
    if (hi - lo == NPH) {
        if (bx == 0) for (int i = (int)threadIdx.x; i < XCD_BAR_WORDS; i += NTHR) __hip_atomic_store((unsigned*)args.ws + i, 0u, __ATOMIC_RELAXED, __HIP_MEMORY_SCOPE_AGENT);
        grid.sync(); }
    if (threadIdx.x == 0 && hi - lo > 1) (void)xb_add((unsigned*)args.ws + XB_XCNT(xb_xcc_id()), 1u);
#define INP(k) ((const float*)ldptr(L, (k)))
#define p_x INP(0)
#define p_cvec INP(1)
#define p_pos ((const int*)ldptr(L, 2))
#define p_w_ada INP(3)
#define p_b_ada INP(4)
#define p_out ((float*)ldptr(L, 34))
#define p_ws ((unsigned char*)ldptr(L, 35))
#define p_modp ((float*)(p_ws + WS_MODP))
#define p_mod ((float*)(p_ws + WS_MOD))
#define p_cid ((int*)(p_ws + WS_CID))
#define p_A16 ((float*)(p_ws + WS_A16))
#define p_CS ((float*)(p_ws + WS_CS))
#define p_SSQ ((unsigned long long*)(p_ws + WS_SSQ))
#define p_BV ((float*)(p_ws + WS_BV))
#define p_GM ((float*)(p_ws + WS_GM))
#define p_W1U ((bf16*)(p_ws + WS_W1U))
#define p_W1D ((bf16*)(p_ws + WS_W1D))
#define p_W2U ((bf16*)(p_ws + WS_W2U))
#define p_W2D ((bf16*)(p_ws + WS_W2D))
#define p_WIN ((bf16*)(p_ws + WS_WIN))
#define p_WOUT ((bf16*)(p_ws + WS_WOUT))
#define p_WGLU ((bf16*)(p_ws + WS_WGLU))
#define p_BE ((bf16*)(p_ws + WS_BE))
#define p_BY ((bf16*)(p_ws + WS_BY))
#define p_HB ((bf16*)(p_ws + WS_HB))
#define p_H ((bf16*)(p_ws + WS_H))
#define p_Q ((bf16*)(p_ws + WS_Q))
#define p_K ((bf16*)(p_ws + WS_K))
#define p_V ((bf16*)(p_ws + WS_V))
#define p_UGS ((bf16*)(p_ws + WS_UGS))
#define p_E ((float*)(p_ws + WS_E))
#define p_O32 ((bf16*)(p_ws + WS_O32))
#define p_YG ((bf16*)(p_ws + WS_YG))
#define p_Y2 ((bf16*)(p_ws + WS_Y2))
#define p_MIX ((bf16*)(p_ws + WS_MIX))
    if (IN(0)) { const int lane = lane_asm(), tid = wave * 64 + lane; (void)tid;
        if (bx < 64) ssm_gen(bx, (LAS float*)L, INP(18), INP(19), INP(20), INP(21), INP(22),
                             INP(23), INP(24), p_BY, p_BE, p_A16, tid);
        for (int t = bx * NTHR + tid; t < M; t += G * NTHR) { const int p = p_pos[t]; p_cid[t] = p >= 0 ? p / 64 : -((63 - p) / 64); }
        for (int i = bx * NTHR + tid; i < M * 8; i += G * NTHR) { const int t = i >> 3, j = i & 7;
            const float inv = (j == 0) ? 1.0f : (j == 1) ? 0.19392274474868576f : (j == 2) ? 0.03760603093086393f : (j == 3) ? 0.007292664737217109f : (j == 4) ? 0.001414213562373095f : (j == 5) ? 0.0002742481756762073f : (j == 6) ? 5.318295896944988e-05f : 1.031338537721246e-05f;
            const float ang = (float)p_pos[t] * inv; p_CS[t * 16 + j] = cosf(ang); p_CS[t * 16 + 8 + j] = sinf(ang); }
        LAS float* scr = (LAS float*)(L + wave * 16384);
        constexpr int I_UP = (DMODEL / 64) * (FF / 32), I_DN = (FF / 64) * (DMODEL / 32), I_IN = (DMODEL / 64) * (NIN / 32), I_GLU = 16 * 32, I_OUT = 32 * 64, I_MOD = 32 * 72;
        constexpr int NTR = 4 * I_UP + 2 * I_DN + I_IN + I_GLU + I_OUT;
        if (bx >= 64 || G <= 64) { const int g0 = (G > 64) ? gw - 64 * NWAVES : gw, gn = (G > 64) ? NGW - 64 * NWAVES : NGW;
            for (int r = g0; r < I_MOD; r += gn) { const int sl = r / 72, cb = r % 72, col = cb * 256 + lane * 4; f32x4 acc = {0.f, 0.f, 0.f, 0.f};
                const float* wp = p_w_ada + (size_t)(sl * 64) * NMOD + col; const float* cp = p_cvec + sl * 64;
#pragma unroll 32
                for (int kk = 0; kk < 64; ++kk) { const float cv = cp[kk]; const float sv = cv / (1.0f + expf(-cv)); acc += *(const f32x4*)(wp + (size_t)kk * NMOD) * sv; }
                *(f32x4*)(p_modp + (size_t)sl * NMOD + col) = acc; } }
#define P0_DECODE(it_, T_) do { int r = (it_); \
            if (r < I_UP) { T_ = TrItem{INP(6), p_W1U, DMODEL, FF, 1, r}; break; } r -= I_UP; \
            if (r < I_UP) { T_ = TrItem{INP(7), p_W1U, DMODEL, FF, 2, r}; break; } r -= I_UP; \
            if (r < I_DN) { T_ = TrItem{INP(8), p_W1D, FF, DMODEL, 0, r}; break; } r -= I_DN; \
            if (r < I_IN) { T_ = TrItem{INP(10), p_WIN, DMODEL, NIN, 3, r}; break; } r -= I_IN; \
            if (r < I_GLU) { T_ = TrItem{INP(26), p_WGLU, 1024, 1024, 0, r}; break; } r -= I_GLU; \
            if (r < I_OUT) { T_ = TrItem{INP(29), p_WOUT, DMODEL, DMODEL, 0, r}; break; } r -= I_OUT; \
            if (r < I_UP) { T_ = TrItem{INP(31), p_W2U, DMODEL, FF, 1, r}; break; } r -= I_UP; \
            if (r < I_UP) { T_ = TrItem{INP(32), p_W2U, DMODEL, FF, 2, r}; break; } r -= I_UP; \
            T_ = TrItem{INP(33), p_W2D, FF, DMODEL, 0, r}; } while (0)
        if (gw < NTR) { TrItem cur, nxt; f32x4 ra[8], rb[8]; int it = gw; P0_DECODE(it, cur); tr_load(cur, lane, ra);
            for (;;) { const int itn = it + NGW; const bool has = itn < NTR;
                if (has) { P0_DECODE(itn, nxt); tr_load(nxt, lane, rb); }
                tr_store(cur, lane, ra, scr);
                if (!has) break;
                it = itn; cur = nxt;
#pragma unroll
                for (int i = 0; i < 8; ++i) ra[i] = rb[i]; } }
#undef P0_DECODE
        __syncthreads();
    }
    SEAM(0);
    if (IN(1)) { const int lane = lane_asm(), tid = wave * 64 + lane; (void)tid;
        for (int j = bx * NTHR + tid; j < NMOD; j += G * NTHR) { float s = p_b_ada[j];
#pragma unroll
            for (int sl = 0; sl < 32; ++sl) s += p_modp[(size_t)sl * NMOD + j];
            const int seg = j / DMODEL; p_mod[j] = (seg == 2 || seg == 8) ? 0.5f * s : s;
            if (seg == 4) p_GM[j - 4 * DMODEL] = INP(9)[j - 4 * DMODEL] * (1.0f + s);
            if (seg == 7) p_GM[DMODEL + j - 7 * DMODEL] = INP(30)[j - 7 * DMODEL] * (1.0f + s); }
    }
    SEAM(1);
    if (IN(2)) { const int lane = lane_asm(), tid = wave * 64 + lane; (void)tid; norm_mod_pass(p_x, INP(5), p_mod + 1 * DMODEL, p_mod + 0 * DMODEL, p_HB, gw, NGW, lane);
        for (int i = bx * NTHR + tid; i < 2 * M; i += G * NTHR) p_SSQ[i] = 0ull;
        for (int p = gw; p < 65536; p += NGW) ((unsigned*)(p_UGS + (size_t)p * 384 + 256))[lane] = 0u;
#pragma unroll
        for (int which = 0; which < 2; ++which) { const bf16* Wt = which == 0 ? p_WIN : p_W2U; const float* shv = p_mod + (which == 0 ? 3 : 6) * DMODEL; float* bvo = p_BV + (which == 0 ? 0 : NIN); const int nrows = which == 0 ? NIN : NUP;
            float shr[32];
#pragma unroll
            for (int j = 0; j < 4; ++j)
#pragma unroll
                for (int e = 0; e < 8; ++e) shr[j * 8 + e] = shv[j * 512 + lane * 8 + e];
            for (int r = gw; r < nrows; r += 4 * NGW) {
                v4u w[4][4];
#pragma unroll
                for (int q = 0; q < 4; ++q) { const int rq = (r + q * NGW < nrows) ? r + q * NGW : r; const bf16* wr_ = Wt + (size_t)rq * DMODEL + lane * 8;
#pragma unroll
                    for (int j = 0; j < 4; ++j) w[q][j] = *(const v4u*)(wr_ + j * 512); }
#pragma unroll
                for (int q = 0; q < 4; ++q) { float acc = 0.f;
#pragma unroll
                    for (int j = 0; j < 4; ++j) { const v4u x = w[q][j];
                        acc += blo(x.x) * shr[j * 8 + 0] + bhi(x.x) * shr[j * 8 + 1] + blo(x.y) * shr[j * 8 + 2] + bhi(x.y) * shr[j * 8 + 3] + blo(x.z) * shr[j * 8 + 4] + bhi(x.z) * shr[j * 8 + 5] + blo(x.w) * shr[j * 8 + 6] + bhi(x.w) * shr[j * 8 + 7]; }
                    acc = wave_sum(acc); if (lane == 0 && r + q * NGW < nrows) bvo[r + q * NGW] = acc; } } }
    }
    SEAM(2);
    if (IN(3)) { pg8::Gemm g{p_HB, p_W1U, DMODEL, DMODEL, DMODEL, 0, 0}; pg8::StaticOrder S; S.init(M, NUP, G, bx); pg8::EpiSwiGLU<false> Ep{p_H, FF, nullptr, nullptr};
        pg8::gemm_phase<pg8::EpiSwiGLU<false>, pg8::StaticOrder, true, true>(L, g, S, Ep, wave); }
    SEAM(3);
    if (IN(4)) { pg8::Gemm g{p_H, p_W1D, FF, FF, FF, 0, 0}; pg8::StaticOrder S; S.init(M, DMODEL, G, bx); pg8::EpiResid<true> Ep{p_x, p_out, DMODEL, p_mod + 2 * DMODEL, p_HB, p_GM, p_SSQ};
        pg8::gemm_phase<pg8::EpiResid<true>, pg8::StaticOrder, true, true>(L, g, S, Ep, wave); }
    SEAM(4);
    if (IN(6)) { pg8::Gemm g{p_HB, p_WIN, DMODEL, DMODEL, DMODEL, 0, 0}; pg8::StaticOrder S; S.init(M, NIN, G, bx); pg8::EpiQKVU Ep{p_Q, (size_t)(WS_K - WS_Q) / 2, p_UGS, INP(11), INP(12), p_CS, attn_body::C2, p_SSQ, p_BV};
        pg8::gemm_phase<pg8::EpiQKVU, pg8::StaticOrder, true, true>(L, g, S, Ep, wave); }
    SEAM(6);
    if (IN(7)) { const int lane = lane_asm(), tid = wave * 64 + lane; (void)tid;
        pg8::Gemm g{p_UGS, p_BE, 64 * 384, 768, 768, 768, (size_t)256 * 768}; pg8::BatchOrder S; S.init(4, 32, G, bx); pg8::EpiF32 Ep{p_E, 8192};
        pg8::gemm_phase<pg8::EpiF32, pg8::BatchOrder, true, true>(L, g, S, Ep, wave);
    }
    SEAM(7);
    if (IN(8)) { const int lane = lane_asm();
        for (int b = bx; b < 256; b += G) { const int g = b >> 2, p = (b & 3) * 16 + (lane & 15), sub = lane >> 4, sg = wave * 4 + sub; LAS float* sl = (LAS float*)L;
            const float ar = p_A16[(g * 64 + p) * 2], ai = p_A16[(g * 64 + p) * 2 + 1];
            const float* Eg = p_E + g * 128 + p + (size_t)(sg * 32) * 8192;
            float sr = 0.f, si = 0.f;
            float er[32], ei[32];
#pragma unroll
            for (int k = 0; k < 32; ++k) { er[k] = Eg[(size_t)k * 8192]; ei[k] = Eg[(size_t)k * 8192 + 64]; }
#pragma unroll
            for (int k = 0; k < 32; ++k) { const float nr = ar * sr - ai * si + er[k], ni = ar * si + ai * sr + ei[k]; sr = nr; si = ni; }
            sl[(sg * 2) * 16 + (lane & 15)] = sr; sl[(sg * 2 + 1) * 16 + (lane & 15)] = si;
            float pr = ar, pi = ai;
#pragma unroll
            for (int k = 0; k < 5; ++k) { const float t = pr * pr - pi * pi; pi = 2.0f * pr * pi; pr = t; }
            __syncthreads();
            float ir = 0.f, ii = 0.f;
            for (int w2 = 0; w2 < 32; ++w2) { if (w2 < sg) { const float lr = sl[(w2 * 2) * 16 + (lane & 15)], li = sl[(w2 * 2 + 1) * 16 + (lane & 15)]; const float nr = pr * ir - pi * ii + lr, ni = pr * ii + pi * ir + li; ir = nr; ii = ni; } }
            sr = ir; si = ii;
            bf16* Ug = p_UGS + (size_t)g * 384 + 256 + p + (size_t)(sg * 32) * (64 * 384);
#pragma unroll
            for (int k = 0; k < 32; ++k) { const size_t o = (size_t)k * (64 * 384); Ug[o] = (bf16)f2bf(sr); Ug[o + 64] = (bf16)f2bf(si);
                const float nr = ar * sr - ai * si + er[k], ni = ar * si + ai * sr + ei[k]; sr = nr; si = ni; }
            __syncthreads();
        }
    }
    SEAM(8);
    if (IN(9)) {
#ifndef P9_NO_SSMY
        { pg8::Gemm g{p_UGS, p_BY, 64 * 384, 384, 384, 384, (size_t)256 * 384}; pg8::BatchOrder S; S.init(4, 64, G, bx); pg8::EpiSsmY Ep{p_UGS, INP(25), p_YG};
          pg8::gemm_phase<pg8::EpiSsmY, pg8::BatchOrder, true, true>(L, g, S, Ep, wave); }
#endif
#ifndef P9_NO_ATTN
        const attn_body::AttnTensors AT{(const attn_body::bf16*)p_Q, (const attn_body::bf16*)p_K, (const attn_body::bf16*)p_V, (attn_body::bf16*)p_O32, p_cid, INP(11), INP(12)};
        const attn_body::StaticOrder S(G, bx);
        attn_body::attn_phase<attn_body::StaticOrder>((char*)lds, AT, S, wave);
#ifdef PROBE_REP_ATTN
        attn_body::attn_phase<attn_body::StaticOrder>((char*)lds, AT, S, wave);
#endif
#endif
    }
    SEAM(9);
    if (IN(10)) { pg8::Gemm g{p_YG, p_WGLU, 1024, 1024, 1024, 0, 0}; pg8::StaticOrder S; S.init(M, 1024, G, bx); pg8::EpiGlu Ep{p_YG, INP(27), p_Y2};
        pg8::gemm_phase<pg8::EpiGlu, pg8::StaticOrder, true, true>(L, g, S, Ep, wave); }
    SEAM(10);
    if (IN(11)) { const int lane = lane_asm(), tid = wave * 64 + lane; (void)tid;
        const float s1 = wave_sum((INP(13))[lane] * (INP(14))[lane]), s2 = wave_sum((INP(15))[lane] * (INP(16))[lane]);
        const float lam_init = 0.2f, lam = expf(s1) - expf(s2) + lam_init;
        float subln[16], ogn[16];
        { const float* sp_ = INP(17) + (lane & 7) * 16; const float* gp_ = INP(28) + lane * 16;
#pragma unroll
          for (int i = 0; i < 16; ++i) { subln[i] = sp_[i]; ogn[i] = gp_[i]; } }
#define MIX_LOAD(dst, rowA) do { _Pragma("unroll") for (int q = 0; q < 2; ++q) { const int rr_ = (rowA) + q * NGW; const size_t ro = (size_t)(rr_ < M ? rr_ : ((rowA) < M ? (rowA) : gw)) * 1024 + lane * 16; \
                dst[q][0] = *(const v4u*)(p_O32 + ro); dst[q][1] = *(const v4u*)(p_O32 + ro + 8); \
                dst[q][2] = *(const v4u*)(p_O32 + (size_t)M * 1024 + ro); dst[q][3] = *(const v4u*)(p_O32 + (size_t)M * 1024 + ro + 8); \
                dst[q][4] = *(const v4u*)(p_Y2 + ro); dst[q][5] = *(const v4u*)(p_Y2 + ro + 8); } } while (0)
        v4u w[2][6], wn[2][6];
        MIX_LOAD(w, gw);
        for (int row = gw; row < M; row += 2 * NGW) {
            const int r1 = (row + NGW < M) ? row + NGW : row;
            MIX_LOAD(wn, row + 2 * NGW);
            asm volatile("" ::: "memory");
#pragma unroll
            for (int q = 0; q < 2; ++q) { const int r = (q == 0 ? row : r1);
                float a[16], b[16];
#define UNP(dst, lo_, hi_) do { dst[0] = blo(lo_.x); dst[1] = bhi(lo_.x); dst[2] = blo(lo_.y); dst[3] = bhi(lo_.y); dst[4] = blo(lo_.z); dst[5] = bhi(lo_.z); dst[6] = blo(lo_.w); dst[7] = bhi(lo_.w); \
                    dst[8] = blo(hi_.x); dst[9] = bhi(hi_.x); dst[10] = blo(hi_.y); dst[11] = bhi(hi_.y); dst[12] = blo(hi_.z); dst[13] = bhi(hi_.z); dst[14] = blo(hi_.w); dst[15] = bhi(hi_.w); } while (0)
                UNP(a, w[q][0], w[q][1]); UNP(b, w[q][2], w[q][3]);
                float ss = 0.f;
#pragma unroll
                for (int i = 0; i < 16; ++i) { a[i] = a[i] - lam * b[i]; ss += a[i] * a[i]; }
                ss += __shfl_xor(ss, 1); ss += __shfl_xor(ss, 2); ss += __shfl_xor(ss, 4);
                const float rstd = (1.0f - lam_init) / sqrtf(ss * (1.0f / 128.0f) + 1e-6f);
#pragma unroll
                for (int i = 0; i < 16; ++i) a[i] = a[i] * rstd * subln[i];
                pack16(p_MIX + (size_t)r * DMODEL + lane * 16, a);
                UNP(b, w[q][4], w[q][5]); float s3 = 0.f;
#undef UNP
#pragma unroll
                for (int i = 0; i < 16; ++i) s3 += b[i] * b[i];
                const float r2 = 1.0f / sqrtf(wave_sum(s3) * (1.0f / 1024.0f) + 1e-6f);
#pragma unroll
                for (int i = 0; i < 16; ++i) b[i] = b[i] * r2 * ogn[i];
                pack16(p_MIX + (size_t)r * DMODEL + 1024 + lane * 16, b); }
#pragma unroll
            for (int q = 0; q < 2; ++q)
#pragma unroll
                for (int i = 0; i < 6; ++i) w[q][i] = wn[q][i];
        }
#undef MIX_LOAD
    }
    SEAM(11);
    if (IN(12)) { pg8::Gemm g{p_MIX, p_WOUT, DMODEL, DMODEL, DMODEL, 0, 0}; pg8::StaticOrder S; S.init(M, DMODEL, G, bx); pg8::EpiResid<true> Ep{p_out, p_out, DMODEL, p_mod + 5 * DMODEL, p_HB, p_GM + DMODEL, p_SSQ + M};
        pg8::gemm_phase<pg8::EpiResid<true>, pg8::StaticOrder, true, true>(L, g, S, Ep, wave); }
    SEAM(12);
    if (IN(14)) { pg8::Gemm g{p_HB, p_W2U, DMODEL, DMODEL, DMODEL, 0, 0}; pg8::StaticOrder S; S.init(M, NUP, G, bx); pg8::EpiSwiGLU<true> Ep{p_H, FF, p_SSQ + M, p_BV + NIN};
        pg8::gemm_phase<pg8::EpiSwiGLU<true>, pg8::StaticOrder, true, true>(L, g, S, Ep, wave); }
    SEAM(14);
    if (IN(15)) { pg8::Gemm g{p_H, p_W2D, FF, FF, FF, 0, 0}; pg8::StaticOrder S; S.init(M, DMODEL, G, bx); pg8::EpiResid<false> Ep{p_out, p_out, DMODEL, p_mod + 8 * DMODEL, nullptr, nullptr, nullptr};
        pg8::gemm_phase<pg8::EpiResid<false>, pg8::StaticOrder, true, true>(L, g, S, Ep, wave); }
#undef IN
#undef SEAM
#undef p_x
#undef p_cvec
#undef p_pos
#undef p_w_ada
#undef p_b_ada
#undef p_out
#undef p_ws
#undef p_modp
#undef p_mod
#undef p_cid
#undef p_A16
#undef p_CS
#undef p_SSQ
#undef p_BV
#undef p_GM
#undef p_W1U
#undef p_W1D
#undef p_W2U
#undef p_W2D
#undef p_WIN
#undef p_WOUT
#undef p_WGLU
#undef p_BE
#undef p_BY
#undef p_HB
#undef p_H
#undef p_Q
#undef p_K
#undef p_V
#undef p_UGS
#undef p_E
#undef p_O32
#undef p_YG
#undef p_Y2
#undef p_MIX
#undef INP
}

extern "C" void kernel_launch(void* const* d_in, const int* in_sizes, int n_in, void* d_out, int out_size, void* d_ws, size_t ws_size, hipStream_t stream) {
    static int grid = 0;
    if (grid == 0) {
        if (n_in != 34 || in_sizes[0] != M * DMODEL || out_size != M * DMODEL || ws_size < WS_END) { fprintf(stderr, "kernel_launch: unexpected shapes (n_in %d, ws %zu)\n", n_in, ws_size); grid = -1; return; }
        int dev = 0, cus = 0, per_cu = 0;
        (void)hipGetDevice(&dev); (void)hipDeviceGetAttribute(&cus, hipDeviceAttributeMultiprocessorCount, dev);
        (void)hipFuncSetAttribute((const void*)mk_fwd, hipFuncAttributeMaxDynamicSharedMemorySize, LDS_BYTES);
        if (hipOccupancyMaxActiveBlocksPerMultiprocessor(&per_cu, (const void*)mk_fwd, NTHR, LDS_BYTES) != hipSuccess || per_cu < 1) per_cu = 1;
        (void)hipGetLastError();
        if (cus <= 0) cus = 256;
        grid = cus * per_cu; if (grid > 256) grid = 256;
    }
    if (grid < 0) return;
    Args a{};
    for (int i = 0; i < 34; ++i) a.in[i] = d_in[i];
    a.out = (float*)d_out; a.ws = (unsigned char*)d_ws;
#if MK_N_LAUNCHES == 1
    a.ph_lo = 0; a.ph_hi = NPH;
    void* kargs[] = {&a};
    hipError_t e = hipLaunchCooperativeKernel((const void*)mk_fwd, dim3(grid), dim3(NTHR), kargs, LDS_BYTES, stream);
    if (e != hipSuccess) {
        fprintf(stderr, "cooperative launch failed: %s (grid %d); falling back to one launch per phase\n", hipGetErrorString(e), grid);
        (void)hipGetLastError();
        for (int ph = 0; ph < NPH; ++ph) { a.ph_lo = ph; a.ph_hi = ph + 1; hipLaunchKernelGGL(mk_fwd, dim3(grid), dim3(NTHR), LDS_BYTES, stream, a); }
    }
#ifdef PROBE_PHASES
    { const int pp[] = {PROBE_PHASES}; for (int ph : pp) { a.ph_lo = ph; a.ph_hi = ph + 1; hipLaunchKernelGGL(mk_fwd, dim3(grid), dim3(NTHR), LDS_BYTES, stream, a); } }
#endif
#else
    for (int ph = 0; ph < NPH; ++ph) { a.ph_lo = ph; a.ph_hi = ph + 1; hipLaunchKernelGGL(mk_fwd, dim3(grid), dim3(NTHR), LDS_BYTES, stream, a); }
#endif
}
```

```cpp
#include <hip/hip_runtime.h>
#include <hip/hip_cooperative_groups.h>
#include <hip/hip_bf16.h>
#include <cstdio>
#include <cstdint>
#include <cmath>
namespace cg = cooperative_groups;
__device__ __forceinline__ int lane_asm() { int l; asm volatile("v_mbcnt_lo_u32_b32 %0, -1, 0\n\tv_mbcnt_hi_u32_b32 %0, -1, %0" : "=v"(l)); return l; }

namespace pg8 {
#define PG8_LAS __attribute__((address_space(3)))
typedef unsigned short bf16_t;
typedef short bf16x8 __attribute__((ext_vector_type(8)));
typedef float f32x4 __attribute__((ext_vector_type(4)));
typedef unsigned u32x4 __attribute__((ext_vector_type(4)));
constexpr int BM = 256, BK = 64, HALF = 128, HTB = HALF * BK * 2  , STAGE_BYTES = 8 * HTB, NXCD = 8, WGM = 8;

__host__ __device__ __forceinline__ int lds_byte(int r, int c) { const int st = (r >> 4) * 2 + (c >> 5), rr = r & 15, cc = c & 31, ob = rr * 64 + cc * 2; return st * 1024 + (ob ^ (((ob >> 9) & 1) << 5)); }
__host__ __device__ __forceinline__ void stage_rc(int b, int& R, int& C) { const int st = b / 1024, sb = b % 1024, swz = sb ^ (((sb >> 9) & 1) << 5); R = (st >> 1) * 16 + swz / 64; C = (st & 1) * 32 + (swz % 64) / 2; }
__host__ __device__ __forceinline__ int perm32(int rho) { const int n = rho >> 4, i = rho & 15; return 8 * (i >> 2) + 4 * n + (i & 3); }

struct Unit { int pm, pn, pz; };
struct Gemm { const bf16_t* A; const bf16_t* Bt; int lda, ldb, K; size_t azs, bzs; };

struct StaticOrder {
    int nM, nN, nwg, G, c;
    __host__ __device__ void init(int M, int N, int G_, int c_) { nM = M / BM; nN = N / BM; nwg = nM * nN; G = G_; c = c_; }
    __host__ __device__ bool next(int i, Unit& u) const {
        const long L = (long)i * G + c; if (L >= nwg) return false;
        int wgid = (int)L; { const int q = nwg / NXCD, r = nwg % NXCD, xcd = wgid % NXCD, off = wgid / NXCD; wgid = (xcd < r ? xcd * (q + 1) : r * (q + 1) + (xcd - r) * q) + off; }
        const int nig = WGM * nN, gid = wgid / nig, fm = gid * WGM, gsz = (nM - fm) < WGM ? (nM - fm) : WGM;
        u.pm = fm + ((wgid % nig) % gsz); u.pn = (wgid % nig) / gsz; u.pz = 0; return true;
    }
};
struct BatchOrder {
    int nM, nun, G, c;
    __host__ __device__ void init(int nM_, int nZ, int G_, int c_) { nM = nM_; nun = nM_ * nZ; G = G_; c = c_; }
    __host__ __device__ bool next(int i, Unit& u) const { const long L = (long)i * G + c; if (L >= nun) return false; u.pz = (int)L / nM; u.pm = (int)L % nM; u.pn = 0; return true; }
};

__device__ __forceinline__ unsigned cvt_pk_bf16(float lo, float hi) { unsigned r; asm volatile("v_cvt_pk_bf16_f32 %0, %1, %2" : "=v"(r) : "v"(lo), "v"(hi)); return r; }
__device__ __forceinline__ float bf_lo(unsigned w) { return __uint_as_float(w << 16); }
__device__ __forceinline__ float bf_hi(unsigned w) { return __uint_as_float(w & 0xffff0000u); }
__device__ __forceinline__ float sigmoid_f(float a) { return __builtin_amdgcn_rcpf(1.0f + __builtin_amdgcn_exp2f(-1.4426950408889634f * a)); }
__device__ __forceinline__ float silu_f(float a) { return a * sigmoid_f(a); }
__device__ __forceinline__ float gelu_tanh_f(float v) {
    const float z = 0.7978845608028654f * (v + 0.044715f * v * v * v); return v * sigmoid_f(2.0f * z);
}
__device__ __forceinline__ u32x4 pack8(const f32x4& v0, const f32x4& v1) { u32x4 w; w.x = cvt_pk_bf16(v0[0], v0[1]); w.y = cvt_pk_bf16(v0[2], v0[3]); w.z = cvt_pk_bf16(v1[0], v1[1]); w.w = cvt_pk_bf16(v1[2], v1[3]); return w; }

__device__ __forceinline__ float rstd_from_ssq(const unsigned long long* ssq, int row) {
    return 1.0f / sqrtf((float)ssq[row] * (1.0f / 16777216.0f) * (1.0f / 2048.0f) + 1e-6f);
}
typedef float f32x2 __attribute__((ext_vector_type(2)));
__device__ __forceinline__ f32x4 swiglu4(const f32x4 a, const f32x4 b) {
    const f32x4 t = a * (-1.4426950408889634f); f32x4 e;
#pragma unroll
    for (int k = 0; k < 4; ++k) e[k] = __builtin_amdgcn_exp2f(t[k]);
    e = e + 1.0f;
#pragma unroll
    for (int k = 0; k < 4; ++k) e[k] = __builtin_amdgcn_rcpf(e[k]);
    return (a * e) * b;
}
template <bool DEFER> struct EpiSwiGLU {
    static constexpr bool PERM = true;
    bf16_t* O; int ldc; const unsigned long long* ssq; const float* bv;
    __device__ __forceinline__ void operator()(const f32x4 (&acc)[2][2][4][2], const Unit& u, int wr, int wc, int fr_, int fq_) const {
        const int l_ = lane_asm(); const int fr = l_ & 15, fq = l_ >> 4; (void)fr_; (void)fq_;
        const int row0 = u.pm * BM + wr * 64 + fr, col0 = u.pn * HALF + wc * 32 + 8 * fq;
        f32x4 ba0 = {0.f, 0.f, 0.f, 0.f}, ba1 = ba0, bb0 = ba0, bb1 = ba0;
        if constexpr (DEFER) { const float* bp = bv + u.pn * BM + wc * 32 + 8 * fq; ba0 = *(const f32x4*)bp; ba1 = *(const f32x4*)(bp + 4); bb0 = *(const f32x4*)(bp + HALF); bb1 = *(const f32x4*)(bp + HALF + 4); }
        float rsv[8];
        if constexpr (DEFER) {
#pragma unroll
            for (int i = 0; i < 8; ++i) rsv[i] = rstd_from_ssq(ssq, row0 + (i >> 2) * HALF + (i & 3) * 16);
            asm volatile("" ::: "memory"); }
#pragma unroll
        for (int ai = 0; ai < 2; ++ai)
#pragma unroll
            for (int m = 0; m < 4; ++m) { const int row = row0 + ai * HALF + m * 16; bf16_t* rowp = O + (size_t)row * ldc + col0;
                f32x4 v0, v1;
                if constexpr (DEFER) { const float rs = rsv[ai * 4 + m];
                    v0 = swiglu4(acc[ai][0][m][0] * rs + ba0, acc[ai][1][m][0] * rs + bb0); v1 = swiglu4(acc[ai][0][m][1] * rs + ba1, acc[ai][1][m][1] * rs + bb1); }
                else { v0 = swiglu4(acc[ai][0][m][0], acc[ai][1][m][0]); v1 = swiglu4(acc[ai][0][m][1], acc[ai][1][m][1]); }
                *(u32x4*)rowp = pack8(v0, v1); }
    }
};
template <bool EMIT> struct EpiResid {
    static constexpr bool PERM = false;
    const float* base; float* out; int ldc; const float* gate;
    bf16_t* A2; const float* gmv; unsigned long long* ssq;
    __device__ __forceinline__ void operator()(const f32x4 (&acc)[2][2][4][2], const Unit& u, int wr, int wc, int fr_, int fq_) const {
        const int l_ = lane_asm(); const int fr = l_ & 15, fq = l_ >> 4; (void)fr_; (void)fq_;
        const int row0 = u.pm * BM + wr * 64 + fr, col0 = u.pn * BM + wc * 32 + 4 * fq;
        f32x4 gv[2][2], gm[2][2];
#pragma unroll
        for (int bj = 0; bj < 2; ++bj)
#pragma unroll
            for (int n = 0; n < 2; ++n) { gv[bj][n] = *(const f32x4*)(gate + col0 + bj * HALF + n * 16);
                if constexpr (EMIT) gm[bj][n] = *(const f32x4*)(gmv + col0 + bj * HALF + n * 16); else gm[bj][n] = gv[bj][n]; }
#pragma unroll
        for (int ai = 0; ai < 2; ++ai)
#pragma unroll
        for (int mh = 0; mh < 2; ++mh) {
            f32x4 bs[2][2][2];
#pragma unroll
            for (int m = 0; m < 2; ++m) { const size_t off = (size_t)(row0 + ai * HALF + (2 * mh + m) * 16) * ldc + col0;
#pragma unroll
                for (int bj = 0; bj < 2; ++bj)
#pragma unroll
                    for (int n = 0; n < 2; ++n) bs[m][bj][n] = *(const f32x4*)(base + off + bj * HALF + n * 16); }
            asm volatile("" ::: "memory");
#pragma unroll
            for (int m = 0; m < 2; ++m) { const int row = row0 + ai * HALF + (2 * mh + m) * 16; const size_t off = (size_t)row * ldc + col0; float ss = 0.f;
#pragma unroll
                for (int bj = 0; bj < 2; ++bj)
#pragma unroll
                    for (int n = 0; n < 2; ++n) { const f32x4 o = bs[m][bj][n] + gv[bj][n] * acc[ai][bj][2 * mh + m][n]; *(f32x4*)(out + off + bj * HALF + n * 16) = o;
                        if constexpr (EMIT) { ss += (o[0] * o[0] + o[1] * o[1]) + (o[2] * o[2] + o[3] * o[3]); const f32x4 y = o * gm[bj][n];
                            typedef unsigned u32x2_t __attribute__((ext_vector_type(2))); u32x2_t w; w.x = cvt_pk_bf16(y[0], y[1]); w.y = cvt_pk_bf16(y[2], y[3]); *(u32x2_t*)(A2 + off + bj * HALF + n * 16) = w; } }
                if constexpr (EMIT) { ss += __shfl_xor(ss, 16); ss += __shfl_xor(ss, 32); if (fq == 0) atomicAdd(ssq + row, (unsigned long long)(ss * 16777216.0f)); } }
            asm volatile("" ::: "memory");
        }
    }
};
struct EpiQKVU {
    static constexpr bool PERM = true;
    bf16_t* Q; size_t qkv_stride; bf16_t* U; const float* qn; const float* kn; const float* cs; float c2; const unsigned long long* ssq; const float* bv;
    __device__ __forceinline__ void operator()(const f32x4 (&acc)[2][2][4][2], const Unit& u, int wr, int wc, int fr_, int fq_) const {
        const int l_ = lane_asm(); const int fr = l_ & 15, fq = l_ >> 4; (void)fr_; (void)fq_;
        const int row0 = u.pm * BM + wr * 64 + fr, t = u.pn >> 2;
        float rsv[8];
#pragma unroll
        for (int i = 0; i < 8; ++i) rsv[i] = rstd_from_ssq(ssq, row0 + (i >> 2) * HALF + (i & 3) * 16);
        asm volatile("" ::: "memory");
        if (t < 2) {
            f32x4 g[2][2];
#pragma unroll
            for (int bj = 0; bj < 2; ++bj)
#pragma unroll
                for (int n = 0; n < 2; ++n) { const f32x4 a = *(const f32x4*)(qn + bj * 32 + 8 * fq + 4 * n), b = *(const f32x4*)(kn + bj * 32 + 8 * fq + 4 * n); g[bj][n] = t == 0 ? a : b; }
            const float sc = t == 0 ? c2 : 1.0f;
            const float* bp = bv + u.pn * BM + wc * 32 + 8 * fq; const f32x4 b00 = *(const f32x4*)bp, b01 = *(const f32x4*)(bp + 4), b10 = *(const f32x4*)(bp + HALF), b11 = *(const f32x4*)(bp + HALF + 4);
            const unsigned long long* sp = ssq + row0;
            bf16_t* rp = Q + (size_t)t * qkv_stride + (size_t)row0 * 1024 + ((u.pn & 3) * 4 + wc) * 64 + 8 * fq;
            const float* cp = cs + (size_t)row0 * 16;
#pragma unroll
            for (int ai = 0; ai < 2; ++ai)
#pragma unroll
                for (int m = 0; m < 4; ++m) {
                    asm volatile("" : "+v"(rp), "+v"(cp), "+v"(sp));
                    const float rs = rsv[ai * 4 + m];
                    f32x4 v00 = acc[ai][0][m][0] * rs + b00, v01 = acc[ai][0][m][1] * rs + b01, v10 = acc[ai][1][m][0] * rs + b10, v11 = acc[ai][1][m][1] * rs + b11;
                    float ss = 0.f;
#pragma unroll
                    for (int k = 0; k < 4; ++k) ss += v00[k] * v00[k] + v01[k] * v01[k] + v10[k] * v10[k] + v11[k] * v11[k];
                    ss += __shfl_xor(ss, 16); ss += __shfl_xor(ss, 32);
                    const float rstd = 1.0f / sqrtf(ss * (1.0f / 64.0f) + 1e-6f);
                    v00 = v00 * rstd * g[0][0]; v01 = v01 * rstd * g[0][1]; v10 = v10 * rstd * g[1][0]; v11 = v11 * rstd * g[1][1];
                    f32x4 p0, p1;
#pragma unroll
                    for (int k = 0; k < 4; ++k) { p0[k] = __shfl_xor(v00[k], 16); p1[k] = __shfl_xor(v01[k], 16); }
                    const f32x4 c0 = *(const f32x4*)(cp), c1 = *(const f32x4*)(cp + 4), s0 = *(const f32x4*)(cp + 8), s1 = *(const f32x4*)(cp + 12);
                    if (fq < 2) {
                        if (fq == 0) { v00 = v00 * c0 - p0 * s0; v01 = v01 * c1 - p1 * s1; } else { v00 = p0 * s0 + v00 * c0; v01 = p1 * s1 + v01 * c1; } }
                    v00 = v00 * sc; v01 = v01 * sc; v10 = v10 * sc; v11 = v11 * sc;
                    *(u32x4*)rp = pack8(v00, v01); *(u32x4*)(rp + 32) = pack8(v10, v11);
                    const int adv = (m == 3) ? (128 - 48) : 16; rp += (size_t)adv * 1024; cp += (size_t)adv * 16; sp += adv; }
            return;
        }
        const int col0 = (u.pn & 3) * BM + wc * 32 + 8 * fq;
        bf16_t* base = Q + (size_t)2 * qkv_stride;
        const float* bp2 = bv + u.pn * BM + wc * 32 + 8 * fq;
        const f32x4 bq[2][2] = {{*(const f32x4*)(bp2), *(const f32x4*)(bp2 + 4)}, {*(const f32x4*)(bp2 + HALF), *(const f32x4*)(bp2 + HALF + 4)}};
        asm volatile("" ::: "memory");
#pragma unroll
        for (int ai = 0; ai < 2; ++ai)
#pragma unroll
            for (int m = 0; m < 4; ++m) { const int row = row0 + ai * HALF + m * 16;
#pragma unroll
                for (int bj = 0; bj < 2; ++bj) { const int col = col0 + bj * HALF; const float rs = rsv[ai * 4 + m];
                    const u32x4 w = pack8(acc[ai][bj][m][0] * rs + bq[bj][0], acc[ai][bj][m][1] * rs + bq[bj][1]);
                    if (t < 3) *(u32x4*)(base + (size_t)row * 1024 + col) = w;
                    else *(u32x4*)(U + ((size_t)((row >> 4) * 64 + (col >> 4)) * 384 + (row & 15) * 16 + (col & 15))) = w; } }
    }
};
struct EpiF32 {
    static constexpr bool PERM = false;
    float* out; int ldc;
    __device__ __forceinline__ void operator()(const f32x4 (&acc)[2][2][4][2], const Unit& u, int wr, int wc, int fr, int fq) const {
        const int row0 = u.pm * BM + wr * 64 + fr, col0 = u.pz * BM + wc * 32 + 4 * fq;
#pragma unroll
        for (int ai = 0; ai < 2; ++ai)
#pragma unroll
            for (int m = 0; m < 4; ++m) { const size_t off = (size_t)(row0 + ai * HALF + m * 16) * ldc + col0;
#pragma unroll
                for (int bj = 0; bj < 2; ++bj)
#pragma unroll
                    for (int n = 0; n < 2; ++n) *(f32x4*)(out + off + bj * HALF + n * 16) = acc[ai][bj][m][n]; }
    }
};
struct EpiSsmY {
    static constexpr bool PERM = true;
    const bf16_t* U; const float* dskip; bf16_t* YG;
    __device__ __forceinline__ void operator()(const f32x4 (&acc)[2][2][4][2], const Unit& u, int wr, int wc, int fr_, int fq_) const {
        const int l_ = lane_asm(); const int fr = l_ & 15, fq = l_ >> 4; (void)fr_; (void)fq_;
        const int row0 = u.pm * BM + wr * 64 + fr, g = u.pz, col0 = wc * 32 + 8 * fq, co0 = col0 & 15;
        const f32x4 d0 = *(const f32x4*)(dskip + g * 16 + co0), d1 = *(const f32x4*)(dskip + g * 16 + co0 + 4);
        const bf16_t* up = U + ((size_t)(row0 * 64 + g) * 384 + col0);
        bf16_t* yp = YG + ((size_t)row0 * 16 + (col0 >> 4)) * 1024 + g * 16 + co0;
        u32x4 uwv[2][2];
#pragma unroll
        for (int ai = 0; ai < 2; ++ai)
#pragma unroll
            for (int m = 0; m < 4; ++m) {
                asm volatile("" : "+v"(up), "+v"(yp));
                if ((m & 1) == 0) {
                    uwv[0][0] = *(const u32x4*)(up); uwv[0][1] = *(const u32x4*)(up + 128);
                    uwv[1][0] = *(const u32x4*)(up + (size_t)16 * 64 * 384); uwv[1][1] = *(const u32x4*)(up + (size_t)16 * 64 * 384 + 128);
                    asm volatile("" ::: "memory"); }
#pragma unroll
                for (int bj = 0; bj < 2; ++bj) {
                    const u32x4 uw = uwv[m & 1][bj];
                    f32x4 v0 = acc[ai][bj][m][0], v1 = acc[ai][bj][m][1];
                    v0[0] += d0[0] * bf_lo(uw.x); v0[1] += d0[1] * bf_hi(uw.x); v0[2] += d0[2] * bf_lo(uw.y); v0[3] += d0[3] * bf_hi(uw.y);
                    v1[0] += d1[0] * bf_lo(uw.z); v1[1] += d1[1] * bf_hi(uw.z); v1[2] += d1[2] * bf_lo(uw.w); v1[3] += d1[3] * bf_hi(uw.w);
#pragma unroll
                    for (int k = 0; k < 4; ++k) { v0[k] = gelu_tanh_f(v0[k]); v1[k] = gelu_tanh_f(v1[k]); }
                    *(u32x4*)(yp + bj * 8 * 1024) = pack8(v0, v1); }
                const int adv = (m == 3) ? (128 - 48) : 16;
                up += (size_t)adv * 64 * 384; yp += (size_t)adv * 16 * 1024; }
    }
};
struct EpiGlu {
    static constexpr bool PERM = true;
    const bf16_t* YG; const float* bias; bf16_t* Y2;
    __device__ __forceinline__ void operator()(const f32x4 (&acc)[2][2][4][2], const Unit& u, int wr, int wc, int fr, int fq) const {
        const int row0 = u.pm * BM + wr * 64 + fr, col0 = u.pn * BM + wc * 32 + 8 * fq;
#pragma unroll
        for (int bj = 0; bj < 2; ++bj) { const int col = col0 + bj * HALF;
            const f32x4 b0 = *(const f32x4*)(bias + col), b1 = *(const f32x4*)(bias + col + 4);
            u32x4 ywv[8];
#pragma unroll
            for (int i = 0; i < 8; ++i) ywv[i] = *(const u32x4*)(YG + (size_t)(row0 + (i >> 2) * HALF + (i & 3) * 16) * 1024 + col);
            asm volatile("" ::: "memory");
#pragma unroll
            for (int ai = 0; ai < 2; ++ai)
#pragma unroll
                for (int m = 0; m < 4; ++m) { const size_t off = (size_t)(row0 + ai * HALF + m * 16) * 1024 + col;
                    const u32x4 yw = ywv[ai * 4 + m];
                    f32x4 v0 = acc[ai][bj][m][0] + b0, v1 = acc[ai][bj][m][1] + b1;
                    v0[0] = bf_lo(yw.x) * sigmoid_f(v0[0]); v0[1] = bf_hi(yw.x) * sigmoid_f(v0[1]); v0[2] = bf_lo(yw.y) * sigmoid_f(v0[2]); v0[3] = bf_hi(yw.y) * sigmoid_f(v0[3]);
                    v1[0] = bf_lo(yw.z) * sigmoid_f(v1[0]); v1[1] = bf_hi(yw.z) * sigmoid_f(v1[1]); v1[2] = bf_lo(yw.w) * sigmoid_f(v1[2]); v1[3] = bf_hi(yw.w) * sigmoid_f(v1[3]);
                    *(u32x4*)(Y2 + off) = pack8(v0, v1); }
            asm volatile("" ::: "memory"); }
    }
};

template <class Epi, class Sched, bool ALIGN_EPI = false, bool SP2 = false>
__device__ __forceinline__ void gemm_phase(PG8_LAS unsigned char* lds, const Gemm g, const Sched& S, const Epi& E, const int wid) {
    const int lane = lane_asm(), tid = wid * 64 + lane, wr = wid >> 2, wc = wid & 3, fr = lane & 15, fq = lane >> 4;
    const int K = g.K, nt = K / BK;
    unsigned voffA[2], voffB[2];
#pragma unroll
    for (int i = 0; i < 2; ++i) { int R, C; stage_rc(tid * 16 + i * 8192, R, C); const int Rb = Epi::PERM ? ((R & ~31) + perm32(R & 31)) : R;
        voffA[i] = (unsigned)(R * g.lda + C) * 2u; voffB[i] = (unsigned)(Rb * g.ldb + C) * 2u; }
    const size_t kstep = (size_t)(BK * 2);
    const size_t hsA = (size_t)HALF * g.lda * 2, hsB = (size_t)HALF * g.ldb * 2;
#define PG8_APTR(u) ((const char*)g.A + ((size_t)(u).pz * g.azs + (size_t)(u).pm * BM * g.lda) * 2)
#define PG8_BPTR(u) ((const char*)g.Bt + ((size_t)(u).pz * g.bzs + (size_t)(u).pn * BM * g.ldb) * 2)
    const unsigned ldsw = (unsigned)wid * 1024u;
    const int aoff = lds_byte(wr * 64 + fr, fq * 8), boff = lds_byte(wc * 32 + fr, fq * 8);
#define PG8_SA(b, h) (((b) * 2 + (h)) * HTB)
#define PG8_SB(b, h) ((4 + (b) * 2 + (h)) * HTB)
#define PG8_STAGE(bufoff, gbase, voff) do { _Pragma("unroll") for (int _i = 0; _i < 2; ++_i) \
        __builtin_amdgcn_global_load_lds((const unsigned*)((const char*)(gbase) + (voff)[_i]), (PG8_LAS unsigned*)(lds + (bufoff) + ldsw + _i * 8192), 16, 0, 0); } while (0)
#define PG8_LDA(dst, b, h) do { _Pragma("unroll") for (int m = 0; m < 4; ++m) _Pragma("unroll") for (int k = 0; k < 2; ++k) dst[m][k] = *(const PG8_LAS bf16x8*)(lds + PG8_SA(b, h) + aoff + m * 2048 + k * 1024); } while (0)
#define PG8_LDB(dst, b, h) do { _Pragma("unroll") for (int n = 0; n < 2; ++n) _Pragma("unroll") for (int k = 0; k < 2; ++k) dst[n][k] = *(const PG8_LAS bf16x8*)(lds + PG8_SB(b, h) + boff + n * 2048 + k * 1024); } while (0)
#define PG8_MMA(ai, bj, At, Bt) do { __builtin_amdgcn_s_setprio(1); _Pragma("unroll") for (int m = 0; m < 4; ++m) _Pragma("unroll") for (int n = 0; n < 2; ++n) _Pragma("unroll") for (int k = 0; k < 2; ++k) \
        acc[ai][bj][m][n] = __builtin_amdgcn_mfma_f32_16x16x32_bf16(Bt[n][k], At[m][k], acc[ai][bj][m][n], 0, 0, 0); __builtin_amdgcn_s_setprio(0); } while (0)
#define PG8_WAIT_V(n) asm volatile("s_waitcnt vmcnt(" #n ")" ::: "memory")
#define PG8_WAIT_L(n) asm volatile("s_waitcnt lgkmcnt(" #n ")" ::: "memory")
#define PG8_BAR __builtin_amdgcn_s_barrier()
#define PG8_SCHED __builtin_amdgcn_sched_barrier(0)
    Unit cur, nxt; int ui = 0;
    if (!S.next(0, cur)) return;
    f32x4 acc[2][2][4][2];
#pragma unroll
    for (int a = 0; a < 2; ++a)
#pragma unroll
        for (int b = 0; b < 2; ++b)
#pragma unroll
            for (int m = 0; m < 4; ++m)
#pragma unroll
                for (int n = 0; n < 2; ++n) acc[a][b][m][n] = (f32x4){0.f, 0.f, 0.f, 0.f};
    bf16x8 At[4][2], B0[2][2], B1[2][2];
    const char* cA = PG8_APTR(cur); const char* cB = PG8_BPTR(cur);
    if constexpr (SP2) {
        PG8_STAGE(PG8_SB(0, 0), cB, voffB); PG8_STAGE(PG8_SB(0, 1), cB + hsB, voffB); PG8_STAGE(PG8_SA(0, 0), cA, voffA); PG8_STAGE(PG8_SA(0, 1), cA + hsA, voffA);
        if (wr == 1) PG8_BAR;
        PG8_WAIT_V(2); PG8_BAR;
        PG8_STAGE(PG8_SB(1, 0), cB + kstep, voffB); PG8_STAGE(PG8_SA(1, 0), cA + kstep, voffA); PG8_STAGE(PG8_SB(1, 1), cB + hsB + kstep, voffB);
        PG8_WAIT_V(6); PG8_BAR;
    } else {
        PG8_STAGE(PG8_SB(0, 0), cB, voffB); PG8_STAGE(PG8_SA(0, 0), cA, voffA); PG8_STAGE(PG8_SB(0, 1), cB + hsB, voffB); PG8_STAGE(PG8_SA(0, 1), cA + hsA, voffA);
        if (wr == 1) PG8_BAR;
        PG8_WAIT_V(4); PG8_BAR;
        PG8_STAGE(PG8_SB(1, 0), cB + kstep, voffB); PG8_STAGE(PG8_SA(1, 0), cA + kstep, voffA); PG8_STAGE(PG8_SB(1, 1), cB + hsB + kstep, voffB);
        PG8_WAIT_V(6); PG8_BAR;
    }
    for (;;) {
        const bool has_next = S.next(ui + 1, nxt);
        const char* nA = has_next ? PG8_APTR(nxt) : cA; const char* nB = has_next ? PG8_BPTR(nxt) : cB;
        for (int t = 0; t < nt; t += 2) {
            const bool last = (t == nt - 2);
            const char* a1 = cA + (size_t)(t + 1) * kstep;
            const char* a2 = last ? nA : cA + (size_t)(t + 2) * kstep; const char* b2 = last ? nB : cB + (size_t)(t + 2) * kstep;
            const char* a3 = a2 + kstep; const char* b3 = b2 + kstep;

            if constexpr (SP2) {
            PG8_LDB(B0, 0, 0); PG8_LDB(B1, 0, 1); PG8_SCHED; PG8_LDA(At, 0, 0); PG8_STAGE(PG8_SA(1, 1), a1 + hsA, voffA);
            PG8_WAIT_V(8); PG8_WAIT_L(0); PG8_BAR; PG8_MMA(0, 0, At, B0); PG8_MMA(0, 1, At, B1); PG8_BAR; PG8_SCHED;
            PG8_LDA(At, 0, 1); PG8_STAGE(PG8_SB(0, 0), b2, voffB); PG8_STAGE(PG8_SB(0, 1), b2 + hsB, voffB); PG8_STAGE(PG8_SA(0, 0), a2, voffA);
            PG8_WAIT_V(8); PG8_WAIT_L(0); PG8_BAR; PG8_MMA(1, 0, At, B0); PG8_MMA(1, 1, At, B1); PG8_BAR; PG8_SCHED;
            PG8_LDB(B0, 1, 0); PG8_LDB(B1, 1, 1); PG8_SCHED; PG8_LDA(At, 1, 0); PG8_STAGE(PG8_SA(0, 1), a2 + hsA, voffA);
            PG8_WAIT_V(8); PG8_WAIT_L(0); PG8_BAR; PG8_MMA(0, 0, At, B0); PG8_MMA(0, 1, At, B1); PG8_BAR; PG8_SCHED;
            PG8_LDA(At, 1, 1); PG8_STAGE(PG8_SB(1, 0), b3, voffB); PG8_STAGE(PG8_SB(1, 1), b3 + hsB, voffB); PG8_STAGE(PG8_SA(1, 0), a3, voffA);
            PG8_WAIT_V(8); PG8_WAIT_L(0); PG8_BAR; PG8_MMA(1, 0, At, B0); PG8_MMA(1, 1, At, B1); PG8_BAR; PG8_SCHED;
            } else {
            PG8_LDB(B0, 0, 0); PG8_SCHED; PG8_LDA(At, 0, 0); PG8_STAGE(PG8_SA(1, 1), a1 + hsA, voffA);
            PG8_WAIT_L(8); PG8_BAR; PG8_WAIT_L(0); PG8_MMA(0, 0, At, B0); PG8_BAR; PG8_SCHED;
            PG8_LDB(B1, 0, 1); PG8_STAGE(PG8_SB(0, 0), b2, voffB);
            PG8_BAR; PG8_WAIT_L(0); PG8_MMA(0, 1, At, B1); PG8_BAR;
            PG8_LDA(At, 0, 1); PG8_STAGE(PG8_SA(0, 0), a2, voffA);
            PG8_BAR; PG8_WAIT_L(0); PG8_MMA(1, 0, At, B0); PG8_BAR; PG8_SCHED;
            PG8_STAGE(PG8_SB(0, 1), b2 + hsB, voffB);
            PG8_WAIT_V(6); PG8_BAR; PG8_MMA(1, 1, At, B1); PG8_BAR;
            PG8_LDB(B0, 1, 0); PG8_SCHED; PG8_LDA(At, 1, 0); PG8_STAGE(PG8_SA(0, 1), a2 + hsA, voffA);
            PG8_WAIT_L(8); PG8_BAR; PG8_WAIT_L(0); PG8_MMA(0, 0, At, B0); PG8_BAR; PG8_SCHED;
            PG8_LDB(B1, 1, 1); PG8_STAGE(PG8_SB(1, 0), b3, voffB);
            PG8_BAR; PG8_WAIT_L(0); PG8_MMA(0, 1, At, B1); PG8_BAR;
            PG8_LDA(At, 1, 1); PG8_STAGE(PG8_SA(1, 0), a3, voffA);
            PG8_BAR; PG8_WAIT_L(0); PG8_MMA(1, 0, At, B0); PG8_BAR; PG8_SCHED;
            PG8_STAGE(PG8_SB(1, 1), b3 + hsB, voffB);
            PG8_WAIT_V(6); PG8_BAR; PG8_MMA(1, 1, At, B1); PG8_BAR;
            }
        }
        if constexpr (ALIGN_EPI) { if (wr == 0) PG8_BAR; }
        E(acc, cur, wr, wc, fr, fq);
        if (!has_next) break;
#pragma unroll
        for (int a = 0; a < 2; ++a)
#pragma unroll
            for (int b = 0; b < 2; ++b)
#pragma unroll
                for (int m = 0; m < 4; ++m)
#pragma unroll
                    for (int n = 0; n < 2; ++n) acc[a][b][m][n] = (f32x4){0.f, 0.f, 0.f, 0.f};
        cur = nxt; cA = nA; cB = nB; ++ui;
        if constexpr (ALIGN_EPI) { if (wr == 1) PG8_BAR; }
    }
    PG8_WAIT_V(0);
    if constexpr (!ALIGN_EPI) { if (wr == 0) PG8_BAR; }
    PG8_BAR;
#undef PG8_SA
#undef PG8_SB
#undef PG8_STAGE
#undef PG8_LDA
#undef PG8_LDB
#undef PG8_MMA
#undef PG8_WAIT_V
#undef PG8_WAIT_L
#undef PG8_BAR
#undef PG8_SCHED
#undef PG8_APTR
#undef PG8_BPTR
}
}
namespace attn_body {
using bf16=__hip_bfloat16;
using bf16x8=__attribute__((ext_vector_type(8)))short;
using s16x4=__attribute__((ext_vector_type(4)))short;
using f32x16=__attribute__((ext_vector_type(16)))float;
using u32x4=__attribute__((ext_vector_type(4)))unsigned;
constexpr int SEQ=16384,D=64,DM=1024;
constexpr int NW=8,QBLK=32,QB=QBLK*NW,KVBLK=64,NQB=SEQ/QB;
constexpr int ATTN_PITCH=DM, ATTN_UNIT_ROWS=QB;
__device__ __forceinline__ int crow(int r,int hi){return (r&3)+8*(r>>2)+4*hi;}
#define SBAR() __builtin_amdgcn_sched_barrier(0)
typedef __attribute__((address_space(3))) const int* lds_iptr;
__device__ __forceinline__ void cmask(f32x16&p0,f32x16&p1,lds_iptr ck,int qc,int hi){
  const float NEG=-INFINITY;
  #pragma unroll
  for(int r=0;r<16;++r){int kv=4*hi+(r&3)+8*(r>>2); if(ck[kv]>qc)p0[r]=NEG; if(ck[kv+32]>qc)p1[r]=NEG;}
}

constexpr int NSLOT=3, SLOTB=8192;
constexpr int LDS_K=0, LDS_V=NSLOT*SLOTB, LDS_WS=3*NSLOT*SLOTB  , LDS_OST=LDS_WS+NW*64*4, LDS_CID=LDS_OST+NW*4096, LDS_BYTES=LDS_CID+1024;
constexpr float C2=0.125f*1.4426950408889634f;
__device__ __forceinline__ void glds16(const void*gsrc,unsigned lds_dst){unsigned keep;
  asm volatile("s_mov_b32 %0, m0\n\ts_mov_b32 m0, %2\n\ts_nop 0\n\tglobal_load_lds_dwordx4 %1, off\n\ts_mov_b32 m0, %0":"=&s"(keep):"v"(gsrc),"s"(lds_dst):"memory");}
__device__ __forceinline__ float max3f(float a,float b,float c){float r;asm("v_max3_f32 %0, %1, %2, %3":"=v"(r):"v"(a),"v"(b),"v"(c));return r;}
__device__ __forceinline__ float max2f(float a,float b){float r;asm("v_max_f32_e32 %0, %1, %2":"=v"(r):"v"(a),"v"(b));return r;}
__device__ __forceinline__ float fadd_s(float a,float b){float r;asm("v_add_f32_e32 %0, %1, %2":"=v"(r):"v"(a),"v"(b));return r;}
__device__ __forceinline__ float fsub_s(float a,float b){float r;asm("v_sub_f32_e32 %0, %1, %2":"=v"(r):"v"(a),"v"(b));return r;}
typedef float f32x2_t __attribute__((ext_vector_type(2))); typedef __bf16 bf16x2_t __attribute__((ext_vector_type(2)));
__device__ __forceinline__ unsigned cvtpk_s(float lo,float hi){f32x2_t v={lo,hi};bf16x2_t b=__builtin_convertvector(v,bf16x2_t);return __builtin_bit_cast(unsigned,b);}
#define WAIT_BAR(N) asm volatile("s_waitcnt vmcnt(" #N ") lgkmcnt(0)\n\ts_barrier":::"memory")

__device__ __forceinline__ void qkt(f32x16&p0,f32x16&p1,const char*Kslot,const bf16x8*qr,int r32,int hi){ const f32x16 negm=f32x16{};
  const char*kb=Kslot+hi*1024+r32*16;
  #pragma unroll
  for(int d0=0;d0<4;++d0){
    const bf16x8 b0=*reinterpret_cast<const bf16x8*>(kb+d0*2048);
    const bf16x8 b1=*reinterpret_cast<const bf16x8*>(kb+d0*2048+512);
    if(d0==0){p0=__builtin_amdgcn_mfma_f32_32x32x16_bf16(b0,qr[0],negm,0,0,0);p1=__builtin_amdgcn_mfma_f32_32x32x16_bf16(b1,qr[0],negm,0,0,0);}
    else{p0=__builtin_amdgcn_mfma_f32_32x32x16_bf16(b0,qr[d0],p0,0,0,0);p1=__builtin_amdgcn_mfma_f32_32x32x16_bf16(b1,qr[d0],p1,0,0,0);}}
}
typedef __attribute__((address_space(3))) const char* lds_cptr;
typedef short v4i16_t __attribute__((ext_vector_type(4)));
__device__ __forceinline__ void kload8(bf16x8*kf,lds_cptr kp){
  kf[0]=*(const __attribute__((address_space(3))) bf16x8*)(kp);      kf[1]=*(const __attribute__((address_space(3))) bf16x8*)(kp+512);
  kf[2]=*(const __attribute__((address_space(3))) bf16x8*)(kp+2048); kf[3]=*(const __attribute__((address_space(3))) bf16x8*)(kp+2560);
  kf[4]=*(const __attribute__((address_space(3))) bf16x8*)(kp+4096); kf[5]=*(const __attribute__((address_space(3))) bf16x8*)(kp+4608);
  kf[6]=*(const __attribute__((address_space(3))) bf16x8*)(kp+6144); kf[7]=*(const __attribute__((address_space(3))) bf16x8*)(kp+6656);
}
__device__ __forceinline__ void kload2(bf16x8*kf,lds_cptr kp,int j){ kf[2*j]=*(const __attribute__((address_space(3))) bf16x8*)(kp+j*2048); kf[2*j+1]=*(const __attribute__((address_space(3))) bf16x8*)(kp+j*2048+512); }
__device__ __forceinline__ s16x4 vtr(lds_cptr p){ return __builtin_bit_cast(s16x4,__builtin_amdgcn_ds_read_tr16_b64_v4i16((__attribute__((address_space(3))) v4i16_t*)p)); }
__device__ __forceinline__ float rowmax(const f32x16&p0,const f32x16&p1){
  float a=max3f(p0[0],p0[1],p1[0]),b=max3f(p0[2],p0[3],p1[1]);a=max3f(a,p1[2],p1[3]);
  #pragma unroll
  for(int r=4;r<16;r+=4){a=max3f(a,p0[r],p0[r+1]);b=max3f(b,p0[r+2],p0[r+3]);a=max3f(a,p1[r],p1[r+1]);b=max3f(b,p1[r+2],p1[r+3]);}
  const float m=max2f(a,b);
  auto rr=__builtin_amdgcn_permlane32_swap(__float_as_uint(m),__float_as_uint(m),false,false);
  return max2f(__uint_as_float(rr[0]),__uint_as_float(rr[1]));
}
__device__ __forceinline__ void pv(f32x16*o,int vb,bf16x8 pa0,bf16x8 pa1,bf16x8 pa2,bf16x8 pa3){
  #pragma unroll
  for(int d0=0;d0<2;++d0){s16x4 lo[4],hi[4];
    #pragma unroll
    for(int ks=0;ks<4;++ks){
      asm volatile("ds_read_b64_tr_b16 %0,%1 offset:%c2":"=&v"(lo[ks]):"v"(vb),"i"(d0*4096+ks*1024):"memory");
      asm volatile("ds_read_b64_tr_b16 %0,%1 offset:%c2":"=&v"(hi[ks]):"v"(vb),"i"(d0*4096+ks*1024+512):"memory");}
    asm volatile("s_waitcnt lgkmcnt(0)":::"memory");SBAR();
    #define PK(k) (bf16x8){lo[k][0],lo[k][1],lo[k][2],lo[k][3],hi[k][0],hi[k][1],hi[k][2],hi[k][3]}
    o[d0]=__builtin_amdgcn_mfma_f32_32x32x16_bf16(pa0,PK(0),o[d0],0,0,0);
    o[d0]=__builtin_amdgcn_mfma_f32_32x32x16_bf16(pa1,PK(1),o[d0],0,0,0);
    o[d0]=__builtin_amdgcn_mfma_f32_32x32x16_bf16(pa2,PK(2),o[d0],0,0,0);
    o[d0]=__builtin_amdgcn_mfma_f32_32x32x16_bf16(pa3,PK(3),o[d0],0,0,0);
    #undef PK
  }
}

#ifndef ATTN_STORE16
#define ATTN_STORE16(p,v) (*(u32x4*)(p)=(v))
#endif
template<int THRL,bool FIXED> __device__ __forceinline__ void attn_unit(int qb,const bf16*Q,const bf16*__restrict__ Kh,const bf16*__restrict__ Vh,bf16*O,const int*__restrict__ cid,char*shm,const int wid){
  const int lane=lane_asm(),tid=wid*64+lane,r32=lane&31,hi=lane>>5;
  const int q0=qb*QB;
  const bf16*Qw=Q+(long)(q0+wid*QBLK)*DM;
  { __attribute__((address_space(3))) int* cw=(__attribute__((address_space(3))) int*)((__attribute__((address_space(3))) char*)shm+LDS_CID); if(tid<256)cw[tid]=cid[q0+tid]; }
  const lds_iptr cidl=(lds_iptr)((__attribute__((address_space(3))) const char*)shm+LDS_CID);
  const unsigned lds0=(unsigned)(uintptr_t)shm;
  float*wsf=(float*)(shm+LDS_WS)+wid*64;
  const bf16*ksrc=Kh+(long)lane*DM+wid*8;
  const bf16*vsrc=Vh+(long)(16*(wid&3)+(lane>>2))*DM+(wid>>2)*32+(lane&3)*8;
  const unsigned kdst=lds0+LDS_K+wid*1024, vdst=lds0+LDS_V+wid*1024;
  #define DMA_K(t,slot) glds16(ksrc+(long)(t)*KVBLK*DM,(unsigned)__builtin_amdgcn_readfirstlane(kdst+(slot)))
  #define DMA_V(t,slot) do{ glds16(vsrc+(long)(t)*KVBLK*DM,(unsigned)__builtin_amdgcn_readfirstlane(vdst+2*(slot))); glds16(vsrc+64+(long)(t)*KVBLK*DM,(unsigned)__builtin_amdgcn_readfirstlane(vdst+2*(slot)+8192)); }while(0)
  const int vb0=(int)(lds0+LDS_V)+((lane>>4)&1)*32+(lane&3)*8+(4*hi+((lane&15)>>2))*64;
  const char*Kbase=shm+LDS_K; bf16x8 kf[8];
  const lds_cptr shm3=(lds_cptr)shm; const lds_cptr kp0=shm3+LDS_K+hi*1024+r32*16; const lds_cptr vp0=shm3+LDS_V+((lane>>4)&1)*32+(lane&3)*8+(4*hi+((lane&15)>>2))*64;
  const int NT=(q0+QB)/KVBLK;
  DMA_K(0,0);DMA_V(0,0);DMA_K(1,SLOTB);
  bf16x8 qr[4];
  #pragma unroll
  for(int d0=0;d0<4;++d0)qr[d0]=*reinterpret_cast<const bf16x8*>(&Qw[(long)r32*DM+d0*16+hi*8]);
  float mhat=0.f,l_reg=0.f;f32x16 o[4];o[0]=f32x16{};o[1]=f32x16{};o[2]=f32x16{};o[3]=f32x16{};
  const int qrel=wid*QBLK+r32;
  #define CMASK(P0,P1,t) do{int jb_=(t)-(NT-4); if(jb_>=0)cmask(P0,P1,cidl+64*jb_,qc,hi);}while(0)
  bool resc=false;
  #define START(P0,P1) do{ resc=false; \
    if constexpr(!FIXED){ const float rm=rowmax(P0,P1); const float dl=rm; mhat=fadd_s(mhat,dl); \
      _Pragma("unroll") for(int r=0;r<16;++r){P0[r]=fsub_s(P0[r],dl);P1[r]=fsub_s(P1[r],dl);} \
      } \
    _Pragma("unroll") for(int r=0;r<16;++r)P0[r]=__builtin_amdgcn_exp2f(P0[r]); }while(0)
  #define RESC() do{ if constexpr(!FIXED) if(resc){ asm volatile("s_waitcnt lgkmcnt(0)":::"memory"); \
      _Pragma("unroll") for(int d_=0;d_<4;++d_) _Pragma("unroll") for(int r=0;r<16;++r)o[d_][r]*=wsf[crow(r,hi)]; } }while(0)
  f32x16 pA0,pA1,pB0,pB1;
  int sl_prev=0,sl_cur=0,sl_next=SLOTB;
  #define ROT() do{sl_prev=sl_cur;sl_cur=sl_next;sl_next=(sl_next==(NSLOT-1)*SLOTB)?0:sl_next+SLOTB;}while(0)
  DMA_K(2,2*SLOTB);
  WAIT_BAR(4);
  const int qc=cidl[qrel];
  qkt(pA0,pA1,Kbase,qr,r32,hi);asm volatile("s_nop 15\n\ts_nop 7":"+v"(pA0),"+v"(pA1));CMASK(pA0,pA1,0);
  START(pA0,pA1);
  _Pragma("unroll") for(int r=0;r<16;++r)pA1[r]=__builtin_amdgcn_exp2f(pA1[r]);
  WAIT_BAR(0);
  DMA_K(3,0);DMA_V(1,SLOTB);
  ROT();
  kload8(kf,kp0+sl_cur);
  WAIT_BAR(3);
  s16x4 vlo[8],vhi[8]; u32x4 pw0,pw1,pw2,pw3;
  #define PKW(P,B) cvtpk_s(P[B],P[B+1])
  #define PAF(k) __builtin_bit_cast(bf16x8,pw##k)
  #define VFR(i) (bf16x8){vlo[i][0],vlo[i][1],vlo[i][2],vlo[i][3],vhi[i][0],vhi[i][1],vhi[i][2],vhi[i][3]}
  #define PIN(x) asm volatile("":"+v"(x))
  #define MX3(a,b,c) __builtin_fmaxf(__builtin_fmaxf((a),(b)),(c))
  #define GAPA(MF,A0,A1,A2,A3,W0,W1,PW) do{ MF; sacc+=A0; sacc+=A1; sacc+=A2; sacc+=A3; PIN(sacc); W0; W1; PIN(PW); SBAR(); }while(0)
  #define EX(v) __builtin_amdgcn_exp2f(v)
  #define GAPB(MF,X,B) do{ MF; X[B]=EX(X[B]); X[B+1]=EX(X[B+1]); X[B+2]=EX(X[B+2]); X[B+3]=EX(X[B+3]); PIN(X); SBAR(); }while(0)
  #define VRD(i) do{ vlo[i]=vtr(vp_+(((i)>>2)*4096+((i)&3)*1024)); vhi[i]=vtr(vp_+(((i)>>2)*4096+((i)&3)*1024+512)); }while(0)
  #define VRD2(i) do{ vlo[i]=vtr(vp_+(8192+((i)>>2)*4096+((i)&3)*1024)); vhi[i]=vtr(vp_+(8192+((i)>>2)*4096+((i)&3)*1024+512)); SBAR(); }while(0)
  #define GAPB2(MF,X,B) do{ MF; if constexpr(FIXED){ X[B]=EX(X[B]); X[B+1]=EX(X[B+1]); } else { X[B]=EX(X[B]-mhat); X[B+1]=EX(X[B+1]-mhat); } PIN(X); SBAR(); }while(0)
  #define KRD(G,j) do{ if(G){ kload2(kf,kp0+sl_next,j); SBAR(); } }while(0)
  #define STEP(C0,C1,P0,P1,t,GK,GV,GL) do{ SBAR(); \
    const lds_cptr vp_=vp0+2*sl_prev; \
    VRD(0); SBAR(); float sacc=(P0[0]+P0[1]); \
    GAPA(C0=__builtin_amdgcn_mfma_f32_32x32x16_bf16(kf[0],qr[0],f32x16{},0,0,0), P0[2],P0[3],P0[4],P0[5],     pw0[0]=PKW(P0,0), pw0[1]=PKW(P0,2), pw0); \
    VRD(4); SBAR(); GAPA(C1=__builtin_amdgcn_mfma_f32_32x32x16_bf16(kf[1],qr[0],f32x16{},0,0,0), P0[6],P0[7],P0[8],P0[9],     pw0[2]=PKW(P0,4), pw0[3]=PKW(P0,6), pw0); \
    VRD(1); SBAR(); GAPA(C0=__builtin_amdgcn_mfma_f32_32x32x16_bf16(kf[2],qr[1],C0,0,0,0),   P0[10],P0[11],P0[12],P0[13], pw1[0]=PKW(P0,8), pw1[1]=PKW(P0,10), pw1); \
    VRD(5); SBAR(); GAPA(C1=__builtin_amdgcn_mfma_f32_32x32x16_bf16(kf[3],qr[1],C1,0,0,0),   P0[14],P0[15],P1[0],P1[1],   pw1[2]=PKW(P0,12),pw1[3]=PKW(P0,14), pw1); \
    VRD(2); SBAR(); GAPA(C0=__builtin_amdgcn_mfma_f32_32x32x16_bf16(kf[4],qr[2],C0,0,0,0),   P1[2],P1[3],P1[4],P1[5],     pw2[0]=PKW(P1,0), pw2[1]=PKW(P1,2), pw2); \
    VRD(6); SBAR(); GAPA(C1=__builtin_amdgcn_mfma_f32_32x32x16_bf16(kf[5],qr[2],C1,0,0,0),   P1[6],P1[7],P1[8],P1[9],     pw2[2]=PKW(P1,4), pw2[3]=PKW(P1,6), pw2); \
    VRD(3); SBAR(); GAPA(C0=__builtin_amdgcn_mfma_f32_32x32x16_bf16(kf[6],qr[3],C0,0,0,0),   P1[10],P1[11],P1[12],P1[13], pw3[0]=PKW(P1,8), pw3[1]=PKW(P1,10), pw3); \
    VRD(7); SBAR(); GAPA(C1=__builtin_amdgcn_mfma_f32_32x32x16_bf16(kf[7],qr[3],C1,0,0,0),   P1[14],P1[15],0.f,0.f,       pw3[2]=PKW(P1,12),pw3[3]=PKW(P1,14), pw3); \
    l_reg+=sacc; \
    if(GK){DMA_K((t)+3,sl_cur);} if(GV){DMA_V((t)+1,sl_next);} \
    CMASK(C0,C1,t); \
    if constexpr(!FIXED){ float a=MX3(C0[0],C0[1],C1[0]),b=MX3(C0[2],C0[3],C1[1]); a=MX3(a,C1[2],C1[3]); \
      _Pragma("unroll") for(int r=4;r<16;r+=4){a=MX3(a,C0[r],C0[r+1]);b=MX3(b,C0[r+2],C0[r+3]);a=MX3(a,C1[r],C1[r+1]);b=MX3(b,C1[r+2],C1[r+3]);} \
      float rm=__builtin_fmaxf(a,b); { auto rr=__builtin_amdgcn_permlane32_swap(__float_as_uint(rm),__float_as_uint(rm),false,false); rm=__builtin_fmaxf(__uint_as_float(rr[0]),__uint_as_float(rr[1])); } \
      rm-=mhat; resc=false; \
      if(__builtin_expect(__any(rm>(float)THRL),0)){ const float dl=__builtin_fmaxf(rm,0.f); mhat+=dl; \
        const float f=__builtin_amdgcn_exp2f(-dl); l_reg*=f; if(hi==0)wsf[r32]=f; resc=true; } \
      } \
    SBAR(); \
    GAPB2(o[0]=__builtin_amdgcn_mfma_f32_32x32x16_bf16(PAF(0),VFR(0),o[0],0,0,0), C0,0); VRD2(0); \
    GAPB2(o[1]=__builtin_amdgcn_mfma_f32_32x32x16_bf16(PAF(0),VFR(4),o[1],0,0,0), C0,2); VRD2(4); \
    KRD(GL,0); GAPB2(o[0]=__builtin_amdgcn_mfma_f32_32x32x16_bf16(PAF(1),VFR(1),o[0],0,0,0), C0,4); VRD2(1); \
    KRD(GL,1); GAPB2(o[1]=__builtin_amdgcn_mfma_f32_32x32x16_bf16(PAF(1),VFR(5),o[1],0,0,0), C0,6); VRD2(5); \
    KRD(GL,2); GAPB2(o[0]=__builtin_amdgcn_mfma_f32_32x32x16_bf16(PAF(2),VFR(2),o[0],0,0,0), C0,8); VRD2(2); \
    KRD(GL,3); GAPB2(o[1]=__builtin_amdgcn_mfma_f32_32x32x16_bf16(PAF(2),VFR(6),o[1],0,0,0), C0,10); VRD2(6); \
    GAPB2(o[0]=__builtin_amdgcn_mfma_f32_32x32x16_bf16(PAF(3),VFR(3),o[0],0,0,0), C0,12); VRD2(3); \
    GAPB2(o[1]=__builtin_amdgcn_mfma_f32_32x32x16_bf16(PAF(3),VFR(7),o[1],0,0,0), C0,14); VRD2(7); \
    GAPB2(o[2]=__builtin_amdgcn_mfma_f32_32x32x16_bf16(PAF(0),VFR(0),o[2],0,0,0), C1,0); \
    GAPB2(o[3]=__builtin_amdgcn_mfma_f32_32x32x16_bf16(PAF(0),VFR(4),o[3],0,0,0), C1,2); \
    GAPB2(o[2]=__builtin_amdgcn_mfma_f32_32x32x16_bf16(PAF(1),VFR(1),o[2],0,0,0), C1,4); \
    GAPB2(o[3]=__builtin_amdgcn_mfma_f32_32x32x16_bf16(PAF(1),VFR(5),o[3],0,0,0), C1,6); \
    GAPB2(o[2]=__builtin_amdgcn_mfma_f32_32x32x16_bf16(PAF(2),VFR(2),o[2],0,0,0), C1,8); \
    GAPB2(o[3]=__builtin_amdgcn_mfma_f32_32x32x16_bf16(PAF(2),VFR(6),o[3],0,0,0), C1,10); \
    GAPB2(o[2]=__builtin_amdgcn_mfma_f32_32x32x16_bf16(PAF(3),VFR(3),o[2],0,0,0), C1,12); \
    GAPB2(o[3]=__builtin_amdgcn_mfma_f32_32x32x16_bf16(PAF(3),VFR(7),o[3],0,0,0), C1,14); \
    }while(0)
  int t=1;
  #undef CMASK
  #define CMASK(P0,P1,t) do{}while(0)
  for(;t+5<NT;t+=2){
    STEP(pB0,pB1,pA0,pA1,t,true,true,true);     WAIT_BAR(3); RESC(); ROT();
    STEP(pA0,pA1,pB0,pB1,t+1,true,true,true);   WAIT_BAR(3); RESC(); ROT();
  }
  #undef CMASK
  #define CMASK(P0,P1,t) do{int jb_=(t)-(NT-4); if(jb_>=0)cmask(P0,P1,cidl+64*jb_,qc,hi);}while(0)
  #define ENDW(tt) do{ if((tt)+3<NT){WAIT_BAR(3);} else if((tt)+2<NT){WAIT_BAR(2);} else {WAIT_BAR(0);} }while(0)
  for(;t+1<NT;t+=2){
    STEP(pB0,pB1,pA0,pA1,t,(t+3<NT),(t+1<NT),(t+1<NT));       ENDW(t);   RESC(); ROT();
    STEP(pA0,pA1,pB0,pB1,t+1,(t+4<NT),(t+2<NT),(t+2<NT));     ENDW(t+1); RESC(); ROT();
  }
  STEP(pB0,pB1,pA0,pA1,NT-1,false,false,false); RESC();
  { float sacc=pB0[0]+pB0[1]; _Pragma("unroll") for(int r=2;r<16;++r)sacc+=pB0[r]; _Pragma("unroll") for(int r=0;r<16;++r)sacc+=pB1[r]; l_reg+=sacc;
    pw0=(u32x4){PKW(pB0,0),PKW(pB0,2),PKW(pB0,4),PKW(pB0,6)};pw1=(u32x4){PKW(pB0,8),PKW(pB0,10),PKW(pB0,12),PKW(pB0,14)};pw2=(u32x4){PKW(pB1,0),PKW(pB1,2),PKW(pB1,4),PKW(pB1,6)};pw3=(u32x4){PKW(pB1,8),PKW(pB1,10),PKW(pB1,12),PKW(pB1,14)};
    SBAR(); pv(o,vb0+2*sl_cur,PAF(0),PAF(1),PAF(2),PAF(3)); pv(o+2,vb0+2*sl_cur+8192,PAF(0),PAF(1),PAF(2),PAF(3)); }
  #undef PKW
  #undef PAF
  #undef VFR
  #undef PIN
  #undef MX3
  #undef GAPA
  #undef GAPB
  #undef EX
  #undef VRD
  #undef VRD2
  #undef GAPB2
  #undef KRD
  #undef STEP
  #undef ENDW
  {auto rr=__builtin_amdgcn_permlane32_swap(__float_as_uint(l_reg),__float_as_uint(l_reg),false,false);l_reg=__uint_as_float(rr[0])+__uint_as_float(rr[1]);}
  if(hi==0)wsf[32+r32]=l_reg;asm volatile("s_waitcnt lgkmcnt(0)":::"memory");
  float rli[16];
  #pragma unroll
  for(int r=0;r<16;++r)rli[r]=__builtin_amdgcn_rcpf(wsf[32+crow(r,hi)]);
  bf16*Ow=O+(long)(q0+wid*QBLK)*DM;
  { bf16*stg=(bf16*)(shm+LDS_OST)+wid*2048;
    #pragma unroll
    for(int e=0;e<2;++e){
      #pragma unroll
      for(int r=0;r<16;++r){const int orow=crow(r,hi);
        #pragma unroll
        for(int d0=0;d0<2;++d0)stg[orow*64+d0*32+r32]=__float2bfloat16(o[2*e+d0][r]*rli[r]);}
      asm volatile("s_waitcnt lgkmcnt(0)":::"memory");
      #pragma unroll
      for(int i=0;i<4;++i){const int row=i*8+(lane>>3),ch=lane&7; const u32x4 v=*(const u32x4*)(stg+row*64+ch*8); ATTN_STORE16(Ow+(long)row*DM+e*64+ch*8,v);}
      asm volatile("s_waitcnt lgkmcnt(0)":::"memory"); } }
  asm volatile("s_waitcnt lgkmcnt(0)\n\ts_barrier":::"memory");
  #undef DMA_K
  #undef DMA_V
  #undef CMASK
  #undef START
  #undef RESC
  #undef ROT
}
constexpr int ATTN_LDS_BYTES=LDS_BYTES;
struct AttnTensors { const bf16* Q; const bf16* K; const bf16* V; bf16* O; const int* cid; const float* qn; const float* kn; };
struct AttnUnit { int bh; int qb; };
struct StaticOrder {
  int vcu,G;
  __device__ __forceinline__ explicit StaticOrder(int grid,int block):vcu((grid%8==0)?(block%8)*(grid/8)+block/8:block),G(grid){}
  __device__ __forceinline__ bool next(int i,AttnUnit&u)const{ const int v=vcu+(i>>2)*G; if(v>=256)return false; const int s=v&15,k=i&3; u.bh=v>>4; u.qb=(k&1)?(32*(k>>1)+31-s):(32*(k>>1)+s); return true; }
};
template<class Sched,int THRL=8> __device__ __forceinline__ void attn_phase(char*lds,const AttnTensors&T,const Sched&S,const int wid){
  bool fixed; { const int l=lane_asm(); float gq=__builtin_fabsf(T.qn[l]),gk=__builtin_fabsf(T.kn[l]);
    #pragma unroll
    for(int o_=1;o_<64;o_<<=1){gq=__builtin_fmaxf(gq,__shfl_xor(gq,o_));gk=__builtin_fmaxf(gk,__shfl_xor(gk,o_));}
    const float bound=C2*64.0f*1.03f*gq*gk; fixed=__builtin_amdgcn_readfirstlane((int)(bound<=60.0f))!=0; }
  AttnUnit u;
  for(int i=0;S.next(i,u);++i){ const int h=u.bh>>1,c=u.bh&1;
    if(fixed) attn_unit<THRL,true>(u.qb,T.Q+u.bh*64,T.K+u.bh*64,T.V+h*128,T.O+(long)c*SEQ*DM+h*128,T.cid,lds,wid);
    else attn_unit<THRL,false>(u.qb,T.Q+u.bh*64,T.K+u.bh*64,T.V+h*128,T.O+(long)c*SEQ*DM+h*128,T.cid,lds,wid); }
}
#undef SBAR
#undef WAIT_BAR
}
#define GAS __attribute__((address_space(1)))
#define LAS __attribute__((address_space(3)))
typedef unsigned short bf16;
typedef unsigned v4u __attribute__((ext_vector_type(4)));
typedef unsigned v2u __attribute__((ext_vector_type(2)));
typedef float f32x4 __attribute__((ext_vector_type(4)));
#define LDS_WAIT() asm volatile("s_waitcnt lgkmcnt(0)" ::: "memory")

constexpr int NWAVES = 8, NTHR = 512;
constexpr int M = 16384, DMODEL = 2048, FF = 5632, NUP = 2 * FF, NIN = 4096, NMOD = 9 * DMODEL;
constexpr int NPH = 16;
#ifndef MK_N_LAUNCHES
#define MK_N_LAUNCHES 1
#endif
constexpr size_t MiB = 1u << 20;
constexpr size_t WS_MODP = 1 * MiB, WS_MOD = 4 * MiB, WS_CID = 4 * MiB + 512 * 1024, WS_A16 = 5 * MiB, WS_CS = 6 * MiB, WS_SSQ = 7 * MiB, WS_BV = 8 * MiB, WS_GM = 9 * MiB;
constexpr size_t WS_W1U = 16 * MiB, WS_W1D = 60 * MiB, WS_W2U = 82 * MiB, WS_W2D = 126 * MiB, WS_WIN = 148 * MiB, WS_WOUT = 164 * MiB, WS_WGLU = 172 * MiB, WS_BE = 174 * MiB, WS_BY = 186 * MiB;
constexpr size_t WS_HB = 198 * MiB, WS_H = 262 * MiB, WS_Q = 262 * MiB, WS_K = 294 * MiB, WS_V = 326 * MiB, WS_UGS = 358 * MiB, WS_E = 406 * MiB, WS_END = 438 * MiB;
constexpr size_t WS_O32 = WS_HB, WS_YG = WS_E, WS_Y2 = WS_Q, WS_MIX = WS_K;
static_assert(WS_H + (size_t)M * FF * 2 <= WS_END && WS_UGS + (size_t)1024 * 64 * 384 * 2 <= WS_E && WS_E + (size_t)1024 * 8192 * 4 <= WS_END, "ws map");
constexpr int LDS_BYTES = 147456;

__device__ __forceinline__ unsigned f2bf(float f) { unsigned u = __builtin_bit_cast(unsigned, f); return (u + 0x7fffu + ((u >> 16) & 1u)) >> 16; }
__device__ __forceinline__ unsigned pk2(float lo, float hi) { return f2bf(lo) | (f2bf(hi) << 16); }
__device__ __forceinline__ float blo(unsigned w) { return __uint_as_float(w << 16); }
__device__ __forceinline__ float bhi(unsigned w) { return __uint_as_float(w & 0xffff0000u); }
__device__ __forceinline__ float wave_sum(float v) {
#pragma unroll
    for (int o = 1; o < 64; o <<= 1) v += __shfl_xor(v, o);
    return v;
}
__device__ __forceinline__ void unpack16(const bf16* p, float (&v)[16]) {
    const v4u a = *(const v4u*)p, b = *(const v4u*)(p + 8);
    v[0] = blo(a.x); v[1] = bhi(a.x); v[2] = blo(a.y); v[3] = bhi(a.y); v[4] = blo(a.z); v[5] = bhi(a.z); v[6] = blo(a.w); v[7] = bhi(a.w);
    v[8] = blo(b.x); v[9] = bhi(b.x); v[10] = blo(b.y); v[11] = bhi(b.y); v[12] = blo(b.z); v[13] = bhi(b.z); v[14] = blo(b.w); v[15] = bhi(b.w);
}
__device__ __forceinline__ void pack16(bf16* p, const float (&v)[16]) {
    v4u a, b; a.x = pk2(v[0], v[1]); a.y = pk2(v[2], v[3]); a.z = pk2(v[4], v[5]); a.w = pk2(v[6], v[7]);
    b.x = pk2(v[8], v[9]); b.y = pk2(v[10], v[11]); b.z = pk2(v[12], v[13]); b.w = pk2(v[14], v[15]);
    *(v4u*)p = a; *(v4u*)(p + 8) = b;
}

__device__ __forceinline__ void p0_transpose_item(const float* W, int K, int N, bf16* WT, int mode, LAS float* scr, int item, int lane) {
    const int nblk = N / 32, kb = item / nblk, nb = item % nblk, k0 = 64 * kb, n0 = 32 * nb;
#pragma unroll 8
    for (int i = 0; i < 32; ++i) { const int kk = 2 * i + (lane >> 5); scr[kk * 33 + (lane & 31)] = W[(size_t)(k0 + kk) * N + n0 + (lane & 31)]; }
    LDS_WAIT(); asm volatile("" ::: "memory");
    const int c = lane & 7;
#pragma unroll
    for (int j = 0; j < 4; ++j) { const int n = (lane >> 3) + 8 * j; const LAS float* s = scr + (8 * c) * 33 + n;
        v4u o; o.x = pk2(s[0 * 33], s[1 * 33]); o.y = pk2(s[2 * 33], s[3 * 33]); o.z = pk2(s[4 * 33], s[5 * 33]); o.w = pk2(s[6 * 33], s[7 * 33]);
        const int nn = n0 + n; const int drow = mode == 0 ? nn : ((nn >> 7) * 256 + (mode == 2 ? 128 : 0) + (nn & 127));
        *(v4u*)(WT + (size_t)drow * K + k0 + 8 * c) = o; }
    LDS_WAIT(); asm volatile("" ::: "memory");
}
struct TrItem { const float* W; bf16* WT; int K, N, mode, item; };
__device__ __forceinline__ void tr_load(const TrItem& t, int lane, f32x4 (&r)[8]) {
    const int nblk = t.N / 32, kb = t.item / nblk, nb = t.item % nblk;
    const float* p = t.W + (size_t)(64 * kb + (lane >> 3)) * t.N + 32 * nb + (lane & 7) * 4;
#pragma unroll
    for (int i = 0; i < 8; ++i) r[i] = *(const f32x4*)(p + (size_t)(8 * i) * t.N);
}
__device__ __forceinline__ void tr_store(const TrItem& t, int lane, const f32x4 (&r)[8], LAS float* scr) {
    const int nblk = t.N / 32, kb = t.item / nblk, nb = t.item % nblk, k0 = 64 * kb, n0 = 32 * nb;
#pragma unroll
    for (int i = 0; i < 8; ++i) { LAS float* d = scr + (8 * i + (lane >> 3)) * 33 + (lane & 7) * 4; d[0] = r[i].x; d[1] = r[i].y; d[2] = r[i].z; d[3] = r[i].w; }
    LDS_WAIT(); asm volatile("" ::: "memory");
    const int c = lane & 7;
#pragma unroll
    for (int j = 0; j < 4; ++j) { const int n = (lane >> 3) + 8 * j; const LAS float* s = scr + (8 * c) * 33 + n;
        v4u o; o.x = pk2(s[0 * 33], s[1 * 33]); o.y = pk2(s[2 * 33], s[3 * 33]); o.z = pk2(s[4 * 33], s[5 * 33]); o.w = pk2(s[6 * 33], s[7 * 33]);
        const int nn = n0 + n; int drow = t.mode == 0 ? nn : ((nn >> 7) * 256 + (t.mode == 2 ? 128 : 0) + (nn & 127));
        if (t.mode == 3) drow = nn < 2048 ? ((nn >> 8) * 256 + ((nn >> 5) & 1) * 128 + ((nn >> 6) & 3) * 32 + (nn & 31)) : nn;
        *(v4u*)(t.WT + (size_t)drow * t.K + k0 + 8 * c) = o; }
    LDS_WAIT(); asm volatile("" ::: "memory");
}
__device__ __forceinline__ void norm_load2(const float* X, int r0, int r1, int lane, f32x4 (&v)[2][8]) {
    const f32x4* x0 = (const f32x4*)(X + (size_t)(r0 < M ? r0 : 0) * DMODEL) + lane; const f32x4* x1 = (const f32x4*)(X + (size_t)(r1 < M ? r1 : 0) * DMODEL) + lane;
#pragma unroll
    for (int j = 0; j < 8; ++j) { v[0][j] = x0[64 * j]; v[1][j] = x1[64 * j]; }
}
__device__ __forceinline__ void norm_store2(bf16* O, int r0, int r1, int lane, const f32x4 (&v)[2][8], const f32x4 (&gm)[8], const f32x4 (&hs)[8]) {
#pragma unroll
    for (int q = 0; q < 2; ++q) { const int r = q == 0 ? r0 : r1; float s = 0.f;
#pragma unroll
        for (int j = 0; j < 8; ++j) s += (v[q][j].x * v[q][j].x + v[q][j].y * v[q][j].y) + (v[q][j].z * v[q][j].z + v[q][j].w * v[q][j].w);
        const float rstd = 1.0f / sqrtf(wave_sum(s) * (1.0f / DMODEL) + 1e-6f);
        if (r < M) { bf16* orow = O + (size_t)r * DMODEL;
#pragma unroll
            for (int j = 0; j < 8; ++j) { const f32x4 y = (v[q][j] * rstd) * gm[j] + hs[j]; v2u o; o.x = pk2(y.x, y.y); o.y = pk2(y.z, y.w); *(v2u*)(orow + 4 * (lane + 64 * j)) = o; } } }
}
__device__ __forceinline__ void norm_mod_pass(const float* X, const float* gam, const float* sc, const float* sh, bf16* O, int gw, int NGW, int lane) {
    f32x4 va[2][8], vb[2][8];
    norm_load2(X, gw, gw + NGW, lane, va);
    f32x4 gm[8], hs[8];
#pragma unroll
    for (int j = 0; j < 8; ++j) { const int col = 4 * (lane + 64 * j); gm[j] = *(const f32x4*)(gam + col) * (*(const f32x4*)(sc + col) + 1.0f); hs[j] = *(const f32x4*)(sh + col); }
    for (int row = gw; row < M; row += 4 * NGW) {
        norm_load2(X, row + 2 * NGW, row + 3 * NGW, lane, vb);
        norm_store2(O, row, row + NGW, lane, va, gm, hs);
        norm_load2(X, row + 4 * NGW, row + 5 * NGW, lane, va);
        norm_store2(O, row + 2 * NGW, row + 3 * NGW, lane, vb, gm, hs);
    }
}
__device__ __forceinline__ void norm_mod_row(const float* xrow, const float* gam, const float* sc, const float* sh, bf16* orow, int lane) {
    const f32x4* xr = (const f32x4*)xrow + lane;
    f32x4 v[8]; float s = 0.f;
#pragma unroll
    for (int j = 0; j < 8; ++j) { v[j] = xr[64 * j]; s += (v[j].x * v[j].x + v[j].y * v[j].y) + (v[j].z * v[j].z + v[j].w * v[j].w); }
    const float rstd = 1.0f / sqrtf(wave_sum(s) * (1.0f / DMODEL) + 1e-6f);
#pragma unroll
    for (int j = 0; j < 8; ++j) { const int col = 4 * (lane + 64 * j);
        const f32x4 g4 = *(const f32x4*)(gam + col), c4 = *(const f32x4*)(sc + col), h4 = *(const f32x4*)(sh + col);
        const f32x4 y = (v[j] * rstd * g4) * (c4 + 1.0f) + h4;
        v2u o; o.x = pk2(y.x, y.y); o.y = pk2(y.z, y.w); *(v2u*)(orow + col) = o; }
}
__device__ __forceinline__ void ssm_gen(int g, LAS float* S, const float* a_re, const float* a_im, const float* log_dt, const float* b_re, const float* b_im,
                                        const float* c_re, const float* c_im, bf16* BY, bf16* BE, float* A16, int tid) {
    LAS float* ljr = S; LAS float* lji = S + 17 * 64;
    LAS float* bbr = S + 2 * 17 * 64; LAS float* bbi = bbr + 1024;
    LAS float* ccr = bbi + 1024; LAS float* cci = ccr + 1024;
    LAS float* km = cci + 1024;
    const float dt = expf(log_dt[g]);
    for (int idx = tid; idx < 17 * 64; idx += NTHR) { const int j = idx >> 6, p = idx & 63;
        const float re = fminf(a_re[g * 64 + p], -1e-4f), im = a_im[g * 64 + p];
        const float mag = expf((float)j * re * dt), ang = (float)j * im * dt;
        ljr[idx] = mag * cosf(ang); lji[idx] = mag * sinf(ang); }
    for (int idx = tid; idx < 1024; idx += NTHR) { const int p = idx >> 4;
        const float re = fminf(a_re[g * 64 + p], -1e-4f), im = a_im[g * 64 + p];
        const float mag = expf(re * dt), ang = im * dt; const float xr = mag * cosf(ang) - 1.0f, xi = mag * sinf(ang);
        const float den = 1.0f / (re * re + im * im); const float qr = (xr * re + xi * im) * den, qi = (xi * re - xr * im) * den;
        const float br = b_re[(size_t)g * 1024 + idx], bi = b_im[(size_t)g * 1024 + idx];
        bbr[idx] = qr * br - qi * bi; bbi[idx] = qr * bi + qi * br;
        ccr[idx] = c_re[(size_t)g * 1024 + idx]; cci[idx] = c_im[(size_t)g * 1024 + idx]; }
    __syncthreads();
    if (tid < 64) { A16[(g * 64 + tid) * 2] = ljr[16 * 64 + tid]; A16[(g * 64 + tid) * 2 + 1] = lji[16 * 64 + tid]; }
    for (int idx = tid; idx < 4096; idx += NTHR) { const int j = idx >> 8, co = (idx >> 4) & 15, ci = idx & 15; float s = 0.f;
        for (int p = 0; p < 64; ++p) { const float cr = ccr[co * 64 + p], cim = cci[co * 64 + p], lr = ljr[j * 64 + p], li = lji[j * 64 + p];
            const float tr = cr * lr - cim * li, ti = cr * li + cim * lr; s += tr * bbr[p * 16 + ci] - ti * bbi[p * 16 + ci]; }
        km[idx] = s; }
    __syncthreads();
    unsigned* BYg = (unsigned*)(BY + (size_t)g * 256 * 384);
    for (int i2 = tid; i2 < 256 * 192; i2 += NTHR) { const int row = i2 / 192, col = (i2 % 192) * 2, tl = row >> 4, co = row & 15; float v[2];
#pragma unroll
        for (int e = 0; e < 2; ++e) { const int cc = col + e;
            if (cc < 256) { const int sl = cc >> 4, ci = cc & 15; v[e] = (tl >= sl) ? km[(tl - sl) * 256 + co * 16 + ci] : 0.f; }
            else { const int q = cc - 256, p = q & 63; const float cr = ccr[co * 64 + p], cim = cci[co * 64 + p], lr = ljr[(tl + 1) * 64 + p], li = lji[(tl + 1) * 64 + p];
                v[e] = (q < 64) ? (cr * lr - cim * li) : -(cr * li + cim * lr); } }
        BYg[i2] = pk2(v[0], v[1]); }
    const int gi = g & 1; unsigned* BEg = (unsigned*)(BE + ((size_t)(g >> 1) * 256 + gi * 128) * 768);
    for (int i2 = tid; i2 < 128 * 384; i2 += NTHR) { const int r = i2 / 384, col = (i2 % 384) * 2, part = r >> 6, p = r & 63; float v[2];
#pragma unroll
        for (int e = 0; e < 2; ++e) { const int c2 = col + e, gj = c2 >= 384 ? 1 : 0, cc = c2 - gj * 384;
            if (gj == gi && cc < 256) { const int sl = cc >> 4, ci = cc & 15; const float lr = ljr[(15 - sl) * 64 + p], li = lji[(15 - sl) * 64 + p], br = bbr[p * 16 + ci], bi = bbi[p * 16 + ci];
                v[e] = part == 0 ? (lr * br - li * bi) : (lr * bi + li * br); }
            else v[e] = 0.f; }
        BEg[i2] = pk2(v[0], v[1]); }
    __syncthreads();
}


#define XB_TMO      128
#define XB_XCNT(j)  (256  + 64 * (j))
#define XB_XSUB(j)  (1280 + 64 * (j))
#define XB_XGEN(j)  (2304 + 64 * (j))
#define XB_TOP      3328
#define XB_TOPGEN   3392
#define XCD_BAR_WORDS 3456
#define XB_SPIN_CAP (1u << 22)
__device__ __forceinline__ unsigned xb_ld(unsigned* p)              { return __hip_atomic_load(p, __ATOMIC_RELAXED, __HIP_MEMORY_SCOPE_AGENT); }
__device__ __forceinline__ unsigned xb_add(unsigned* p, unsigned v) { return __hip_atomic_fetch_add(p, v, __ATOMIC_RELAXED, __HIP_MEMORY_SCOPE_AGENT); }
__device__ __forceinline__ unsigned xb_xcc_id() { return (unsigned)__builtin_amdgcn_s_getreg((3 << 11) | 20) & 0xFu; }
#define XB_SPIN(cond, bar) do { unsigned _sp = 0; while (cond) { __builtin_amdgcn_s_sleep(1); \
    if ((++_sp & 255u) == 0u) { if (xb_ld(&(bar)[XB_TMO])) break; if (_sp > XB_SPIN_CAP) { atomicAdd(&(bar)[XB_TMO], 1u); break; } } } } while (0)
__device__ __forceinline__ void xcd_barrier_complete(unsigned* bar, unsigned x, unsigned& nloc, unsigned& nx) {
    const unsigned G = gridDim.x * gridDim.y * gridDim.z;
    unsigned sum, cnt, mine, sp = 0u;
    for (;;) {
        sum = 0u; cnt = 0u; mine = 0u;
#pragma unroll
        for (unsigned j = 0; j < 16; ++j) { const unsigned c = xb_ld(&bar[XB_XCNT(j)]); sum += c; cnt += (c > 0u) ? 1u : 0u; mine = (j == x) ? c : mine; }
        if (sum == G) break;
        __builtin_amdgcn_s_sleep(1);
        if ((++sp & 255u) == 0u) { if (xb_ld(&bar[XB_TMO])) break; if (sp > XB_SPIN_CAP) { atomicAdd(&bar[XB_TMO], 1u); break; } }
    }
    nloc = mine > 0u ? mine : 1u; nx = cnt > 0u ? cnt : 1u;
}
__device__ __forceinline__ void xcd_barrier(unsigned* bar, volatile LAS unsigned* st, bool lead) {
    asm volatile("s_waitcnt vmcnt(0)" ::: "memory");
    __syncthreads();
    if (lead) {
        __builtin_amdgcn_s_waitcnt(0);
        const unsigned x = xb_xcc_id();
        unsigned nloc = st[0], nx = st[1];
        if (nloc == 0u) { xcd_barrier_complete(bar, x, nloc, nx); st[0] = nloc; st[1] = nx; }
        const unsigned old = xb_add(&bar[XB_XSUB(x)], 1u);
        const unsigned gen = old / nloc;
        if (old + 1u == (gen + 1u) * nloc) {
            __builtin_amdgcn_fence(__ATOMIC_RELEASE, "agent");
            asm volatile("s_waitcnt vmcnt(0)" ::: "memory");
            const unsigned og = xb_add(&bar[XB_TOP], 1u);
            const unsigned tg = og / nx;
            if (og + 1u == (tg + 1u) * nx) xb_add(&bar[XB_TOPGEN], 1u);
            else XB_SPIN(xb_ld(&bar[XB_TOPGEN]) == tg, bar);
            __builtin_amdgcn_fence(__ATOMIC_ACQUIRE, "agent");
            xb_add(&bar[XB_XGEN(x)], 1u);
            asm volatile("s_waitcnt vmcnt(0)" ::: "memory");
        } else {
            XB_SPIN(xb_ld(&bar[XB_XGEN(x)]) == gen, bar);
            __builtin_amdgcn_fence(__ATOMIC_ACQUIRE, "agent");
            asm volatile("s_waitcnt vmcnt(0)" ::: "memory");
        }
    }
    __syncthreads();
}
#define FB_REL 8256
constexpr int TAB_OFF = 131072;
__device__ __forceinline__ const void* ldptr(LAS unsigned char* L, int k) {
    const LAS unsigned* t = (const LAS unsigned*)(L + TAB_OFF) + 2 * k;
    const unsigned lo = __builtin_amdgcn_readfirstlane(t[0]), hi = __builtin_amdgcn_readfirstlane(t[1]);
    return (const void*)(((unsigned long long)hi << 32) | lo);
}
struct Args { const void* in[34]; float* out; unsigned char* ws; int ph_lo, ph_hi; };
static_assert(sizeof(Args) == 34 * 8 + 8 + 8 + 8, "Args has no padding");

__global__ void __launch_bounds__(NTHR, 2) mk_fwd(Args args) {
    extern __shared__ __attribute__((aligned(16))) unsigned char lds[];
    LAS unsigned char* L = (LAS unsigned char*)lds;
    const int wave = __builtin_amdgcn_readfirstlane((int)threadIdx.x >> 6);
    const int G = gridDim.x, bx = blockIdx.x;
    const int gw = bx * NWAVES + wave, NGW = G * NWAVES;
    cg::grid_group grid = cg::this_grid();
    const int lo = args.ph_lo, hi = args.ph_hi;
#ifndef PHMASK
#define PHMASK 0xffff
#endif
#define IN(k) (((PHMASK >> (k)) & 1) && lo <= (k) && (k) < hi)
#define SEAM(k) do { if (IN(k) && IN((k) + 1)) xcd_barrier((unsigned*)p_ws, (volatile LAS unsigned*)(L + TAB_OFF + 512), wave == 0 && lane_asm() == 0); } while (0)
    if (threadIdx.x == 0) { LAS unsigned long long* tb = (LAS unsigned long long*)(L + TAB_OFF);
#pragma unroll
        for (int i = 0; i < 34; ++i) tb[i] = (unsigned long long)args.in[i];
        tb[34] = (unsigned long long)args.out; tb[35] = (unsigned long long)args.ws; ((LAS unsigned*)(L + TAB_OFF + 512))[0] = 0u; ((LAS unsigned*)(L + TAB_OFF + 512))[1] = 0u; }
    __syncthreads();
    if (hi - lo == NPH) {
        if (bx == 0) { for (int i = (int)threadIdx.x; i < XCD_BAR_WORDS; i += NTHR) __hip_atomic_store((unsigned*)args.ws + i, 0u, __ATOMIC_RELAXED, __HIP_MEMORY_SCOPE_AGENT);
            asm volatile("s_waitcnt vmcnt(0)" ::: "memory"); __syncthreads();
            if (threadIdx.x == 0) { __builtin_amdgcn_fence(__ATOMIC_RELEASE, "agent"); asm volatile("s_waitcnt vmcnt(0)" ::: "memory"); __hip_atomic_store((unsigned*)args.ws + FB_REL, 1u, __ATOMIC_RELAXED, __HIP_MEMORY_SCOPE_AGENT); } }
        if (hi < 0) grid.sync();
    }
#define INP(k) ((const float*)ldptr(L, (k)))
#define p_x INP(0)
#define p_cvec INP(1)
#define p_pos ((const int*)ldptr(L, 2))
#define p_w_ada INP(3)
#define p_b_ada INP(4)
#define p_out ((float*)ldptr(L, 34))
#define p_ws ((unsigned char*)ldptr(L, 35))
#define p_modp ((float*)(p_ws + WS_MODP))
#define p_mod ((float*)(p_ws + WS_MOD))
#define p_cid ((int*)(p_ws + WS_CID))
#define p_A16 ((float*)(p_ws + WS_A16))
#define p_CS ((float*)(p_ws + WS_CS))
#define p_SSQ ((unsigned long long*)(p_ws + WS_SSQ))
#define p_BV ((float*)(p_ws + WS_BV))
#define p_GM ((float*)(p_ws + WS_GM))
#define p_W1U ((bf16*)(p_ws + WS_W1U))
#define p_W1D ((bf16*)(p_ws + WS_W1D))
#define p_W2U ((bf16*)(p_ws + WS_W2U))
#define p_W2D ((bf16*)(p_ws + WS_W2D))
#define p_WIN ((bf16*)(p_ws + WS_WIN))
#define p_WOUT ((bf16*)(p_ws + WS_WOUT))
#define p_WGLU ((bf16*)(p_ws + WS_WGLU))
#define p_BE ((bf16*)(p_ws + WS_BE))
#define p_BY ((bf16*)(p_ws + WS_BY))
#define p_HB ((bf16*)(p_ws + WS_HB))
#define p_H ((bf16*)(p_ws + WS_H))
#define p_Q ((bf16*)(p_ws + WS_Q))
#define p_K ((bf16*)(p_ws + WS_K))
#define p_V ((bf16*)(p_ws + WS_V))
#define p_UGS ((bf16*)(p_ws + WS_UGS))
#define p_E ((float*)(p_ws + WS_E))
#define p_O32 ((bf16*)(p_ws + WS_O32))
#define p_YG ((bf16*)(p_ws + WS_YG))
#define p_Y2 ((bf16*)(p_ws + WS_Y2))
#define p_MIX ((bf16*)(p_ws + WS_MIX))
    if (IN(0)) { const int lane = lane_asm(), tid = wave * 64 + lane; (void)tid;
        if (bx < 64) ssm_gen(bx, (LAS float*)L, INP(18), INP(19), INP(20), INP(21), INP(22),
                             INP(23), INP(24), p_BY, p_BE, p_A16, tid);
        for (int t = bx * NTHR + tid; t < M; t += G * NTHR) { const int p = p_pos[t]; p_cid[t] = p >= 0 ? p / 64 : -((63 - p) / 64); }
        for (int i = bx * NTHR + tid; i < M * 8; i += G * NTHR) { const int t = i >> 3, j = i & 7;
            const float inv = (j == 0) ? 1.0f : (j == 1) ? 0.19392274474868576f : (j == 2) ? 0.03760603093086393f : (j == 3) ? 0.007292664737217109f : (j == 4) ? 0.001414213562373095f : (j == 5) ? 0.0002742481756762073f : (j == 6) ? 5.318295896944988e-05f : 1.031338537721246e-05f;
            const float ang = (float)p_pos[t] * inv; p_CS[t * 16 + j] = cosf(ang); p_CS[t * 16 + 8 + j] = sinf(ang); }
        LAS float* scr = (LAS float*)(L + wave * 16384);
        constexpr int I_UP = (DMODEL / 64) * (FF / 32), I_DN = (FF / 64) * (DMODEL / 32), I_IN = (DMODEL / 64) * (NIN / 32), I_GLU = 16 * 32, I_OUT = 32 * 64, I_MOD = 32 * 72;
        constexpr int NTR = 4 * I_UP + 2 * I_DN + I_IN + I_GLU + I_OUT;
        if (bx >= 64 || G <= 64) { const int g0 = (G > 64) ? gw - 64 * NWAVES : gw, gn = (G > 64) ? NGW - 64 * NWAVES : NGW;
            for (int r = g0; r < I_MOD; r += gn) { const int sl = r / 72, cb = r % 72, col = cb * 256 + lane * 4; f32x4 acc = {0.f, 0.f, 0.f, 0.f};
                const float* wp = p_w_ada + (size_t)(sl * 64) * NMOD + col; const float* cp = p_cvec + sl * 64;
#pragma unroll 32
                for (int kk = 0; kk < 64; ++kk) { const float cv = cp[kk]; const float sv = cv / (1.0f + expf(-cv)); acc += *(const f32x4*)(wp + (size_t)kk * NMOD) * sv; }
                *(f32x4*)(p_modp + (size_t)sl * NMOD + col) = acc; } }
#define P0_DECODE(it_, T_) do { int r = (it_); \
            if (r < I_UP) { T_ = TrItem{INP(6), p_W1U, DMODEL, FF, 1, r}; break; } r -= I_UP; \
            if (r < I_UP) { T_ = TrItem{INP(7), p_W1U, DMODEL, FF, 2, r}; break; } r -= I_UP; \
            if (r < I_DN) { T_ = TrItem{INP(8), p_W1D, FF, DMODEL, 0, r}; break; } r -= I_DN; \
            if (r < I_IN) { T_ = TrItem{INP(10), p_WIN, DMODEL, NIN, 3, r}; break; } r -= I_IN; \
            if (r < I_GLU) { T_ = TrItem{INP(26), p_WGLU, 1024, 1024, 0, r}; break; } r -= I_GLU; \
            if (r < I_OUT) { T_ = TrItem{INP(29), p_WOUT, DMODEL, DMODEL, 0, r}; break; } r -= I_OUT; \
            if (r < I_UP) { T_ = TrItem{INP(31), p_W2U, DMODEL, FF, 1, r}; break; } r -= I_UP; \
            if (r < I_UP) { T_ = TrItem{INP(32), p_W2U, DMODEL, FF, 2, r}; break; } r -= I_UP; \
            T_ = TrItem{INP(33), p_W2D, FF, DMODEL, 0, r}; } while (0)
        if (gw < NTR) { TrItem cur, nxt; f32x4 ra[8], rb[8]; int it = gw; P0_DECODE(it, cur); tr_load(cur, lane, ra);
            for (;;) { const int itn = it + NGW; const bool has = itn < NTR;
                if (has) { P0_DECODE(itn, nxt); tr_load(nxt, lane, rb); }
                tr_store(cur, lane, ra, scr);
                if (!has) break;
                it = itn; cur = nxt;
#pragma unroll
                for (int i = 0; i < 8; ++i) ra[i] = rb[i]; } }
#undef P0_DECODE
        __syncthreads();
    }
    if (IN(0) && IN(1)) { if (wave == 0 && lane_asm() == 0) { unsigned* ctl_ = (unsigned*)p_ws; unsigned sp_ = 0;
            while (__hip_atomic_load(ctl_ + FB_REL, __ATOMIC_RELAXED, __HIP_MEMORY_SCOPE_AGENT) != 1u) { __builtin_amdgcn_s_sleep(1); if (++sp_ > (1u << 22)) break; }
            __builtin_amdgcn_fence(__ATOMIC_ACQUIRE, "agent"); asm volatile("s_waitcnt vmcnt(0)" ::: "memory");
            (void)xb_add(ctl_ + XB_XCNT(xb_xcc_id()), 1u); }
        xcd_barrier((unsigned*)p_ws, (volatile LAS unsigned*)(L + TAB_OFF + 512), wave == 0 && lane_asm() == 0); }
    if (IN(1)) { const int lane = lane_asm(), tid = wave * 64 + lane; (void)tid;
        for (int j = bx * NTHR + tid; j < NMOD; j += G * NTHR) { float s = p_b_ada[j];
#pragma unroll
            for (int sl = 0; sl < 32; ++sl) s += p_modp[(size_t)sl * NMOD + j];
            const int seg = j / DMODEL; p_mod[j] = (seg == 2 || seg == 8) ? 0.5f * s : s;
            if (seg == 4) p_GM[j - 4 * DMODEL] = INP(9)[j - 4 * DMODEL] * (1.0f + s);
            if (seg == 7) p_GM[DMODEL + j - 7 * DMODEL] = INP(30)[j - 7 * DMODEL] * (1.0f + s); }
    }
    SEAM(1);
    if (IN(2)) { const int lane = lane_asm(), tid = wave * 64 + lane; (void)tid; norm_mod_pass(p_x, INP(5), p_mod + 1 * DMODEL, p_mod + 0 * DMODEL, p_HB, gw, NGW, lane);
        for (int i = bx * NTHR + tid; i < 2 * M; i += G * NTHR) p_SSQ[i] = 0ull;
        for (int p = gw; p < 65536; p += NGW) ((unsigned*)(p_UGS + (size_t)p * 384 + 256))[lane] = 0u;
#pragma unroll
        for (int which = 0; which < 2; ++which) { const bf16* Wt = which == 0 ? p_WIN : p_W2U; const float* shv = p_mod + (which == 0 ? 3 : 6) * DMODEL; float* bvo = p_BV + (which == 0 ? 0 : NIN); const int nrows = which == 0 ? NIN : NUP;
            float shr[32];
#pragma unroll
            for (int j = 0; j < 4; ++j)
#pragma unroll
                for (int e = 0; e < 8; ++e) shr[j * 8 + e] = shv[j * 512 + lane * 8 + e];
            for (int r = gw; r < nrows; r += 4 * NGW) {
                v4u w[4][4];
#pragma unroll
                for (int q = 0; q < 4; ++q) { const int rq = (r + q * NGW < nrows) ? r + q * NGW : r; const bf16* wr_ = Wt + (size_t)rq * DMODEL + lane * 8;
#pragma unroll
                    for (int j = 0; j < 4; ++j) w[q][j] = *(const v4u*)(wr_ + j * 512); }
#pragma unroll
                for (int q = 0; q < 4; ++q) { float acc = 0.f;
#pragma unroll
                    for (int j = 0; j < 4; ++j) { const v4u x = w[q][j];
                        acc += blo(x.x) * shr[j * 8 + 0] + bhi(x.x) * shr[j * 8 + 1] + blo(x.y) * shr[j * 8 + 2] + bhi(x.y) * shr[j * 8 + 3] + blo(x.z) * shr[j * 8 + 4] + bhi(x.z) * shr[j * 8 + 5] + blo(x.w) * shr[j * 8 + 6] + bhi(x.w) * shr[j * 8 + 7]; }
                    acc = wave_sum(acc); if (lane == 0 && r + q * NGW < nrows) bvo[r + q * NGW] = acc; } } }
    }
    SEAM(2);
    if (IN(3)) { pg8::Gemm g{p_HB, p_W1U, DMODEL, DMODEL, DMODEL, 0, 0}; pg8::StaticOrder S; S.init(M, NUP, G, bx); pg8::EpiSwiGLU<false> Ep{p_H, FF, nullptr, nullptr};
        pg8::gemm_phase<pg8::EpiSwiGLU<false>, pg8::StaticOrder, true, true>(L, g, S, Ep, wave); }
    SEAM(3);
    if (IN(4)) { pg8::Gemm g{p_H, p_W1D, FF, FF, FF, 0, 0}; pg8::StaticOrder S; S.init(M, DMODEL, G, bx); pg8::EpiResid<true> Ep{p_x, p_out, DMODEL, p_mod + 2 * DMODEL, p_HB, p_GM, p_SSQ};
        pg8::gemm_phase<pg8::EpiResid<true>, pg8::StaticOrder, true, true>(L, g, S, Ep, wave); }
    SEAM(4);
    if (IN(6)) { pg8::Gemm g{p_HB, p_WIN, DMODEL, DMODEL, DMODEL, 0, 0}; pg8::StaticOrder S; S.init(M, NIN, G, bx); pg8::EpiQKVU Ep{p_Q, (size_t)(WS_K - WS_Q) / 2, p_UGS, INP(11), INP(12), p_CS, attn_body::C2, p_SSQ, p_BV};
        pg8::gemm_phase<pg8::EpiQKVU, pg8::StaticOrder, true, true>(L, g, S, Ep, wave); }
    SEAM(6);
    if (IN(7)) { const int lane = lane_asm(), tid = wave * 64 + lane; (void)tid;
        pg8::Gemm g{p_UGS, p_BE, 64 * 384, 768, 768, 768, (size_t)256 * 768}; pg8::BatchOrder S; S.init(4, 32, G, bx); pg8::EpiF32 Ep{p_E, 8192};
        pg8::gemm_phase<pg8::EpiF32, pg8::BatchOrder, true, true>(L, g, S, Ep, wave);
    }
    SEAM(7);
    if (IN(8)) { const int lane = lane_asm();
        for (int b = bx; b < 256; b += G) { const int g = b >> 2, p = (b & 3) * 16 + (lane & 15), sub = lane >> 4, sg = wave * 4 + sub; LAS float* sl = (LAS float*)L;
            const float ar = p_A16[(g * 64 + p) * 2], ai = p_A16[(g * 64 + p) * 2 + 1];
            const float* Eg = p_E + g * 128 + p + (size_t)(sg * 32) * 8192;
            float sr = 0.f, si = 0.f;
            float er[32], ei[32];
#pragma unroll
            for (int k = 0; k < 32; ++k) { er[k] = Eg[(size_t)k * 8192]; ei[k] = Eg[(size_t)k * 8192 + 64]; }
#pragma unroll
            for (int k = 0; k < 32; ++k) { const float nr = ar * sr - ai * si + er[k], ni = ar * si + ai * sr + ei[k]; sr = nr; si = ni; }
            sl[(sg * 2) * 16 + (lane & 15)] = sr; sl[(sg * 2 + 1) * 16 + (lane & 15)] = si;
            float pr = ar, pi = ai;
#pragma unroll
            for (int k = 0; k < 5; ++k) { const float t = pr * pr - pi * pi; pi = 2.0f * pr * pi; pr = t; }
            __syncthreads();
            float ir = 0.f, ii = 0.f;
            for (int w2 = 0; w2 < 32; ++w2) { if (w2 < sg) { const float lr = sl[(w2 * 2) * 16 + (lane & 15)], li = sl[(w2 * 2 + 1) * 16 + (lane & 15)]; const float nr = pr * ir - pi * ii + lr, ni = pr * ii + pi * ir + li; ir = nr; ii = ni; } }
            sr = ir; si = ii;
            bf16* Ug = p_UGS + (size_t)g * 384 + 256 + p + (size_t)(sg * 32) * (64 * 384);
#pragma unroll
            for (int k = 0; k < 32; ++k) { const size_t o = (size_t)k * (64 * 384); Ug[o] = (bf16)f2bf(sr); Ug[o + 64] = (bf16)f2bf(si);
                const float nr = ar * sr - ai * si + er[k], ni = ar * si + ai * sr + ei[k]; sr = nr; si = ni; }
            __syncthreads();
        }
    }
    SEAM(8);
    if (IN(9)) {
#ifndef P9_NO_SSMY
        { pg8::Gemm g{p_UGS, p_BY, 64 * 384, 384, 384, 384, (size_t)256 * 384}; pg8::BatchOrder S; S.init(4, 64, G, bx); pg8::EpiSsmY Ep{p_UGS, INP(25), p_YG};
          pg8::gemm_phase<pg8::EpiSsmY, pg8::BatchOrder, true, true>(L, g, S, Ep, wave); }
#endif
#ifndef P9_NO_ATTN
        const attn_body::AttnTensors AT{(const attn_body::bf16*)p_Q, (const attn_body::bf16*)p_K, (const attn_body::bf16*)p_V, (attn_body::bf16*)p_O32, p_cid, INP(11), INP(12)};
        const attn_body::StaticOrder S(G, bx);
        attn_body::attn_phase<attn_body::StaticOrder>((char*)lds, AT, S, wave);
#ifdef PROBE_REP_ATTN
        attn_body::attn_phase<attn_body::StaticOrder>((char*)lds, AT, S, wave);
#endif
#endif
    }
    SEAM(9);
    if (IN(10)) { pg8::Gemm g{p_YG, p_WGLU, 1024, 1024, 1024, 0, 0}; pg8::StaticOrder S; S.init(M, 1024, G, bx); pg8::EpiGlu Ep{p_YG, INP(27), p_Y2};
        pg8::gemm_phase<pg8::EpiGlu, pg8::StaticOrder, true, true>(L, g, S, Ep, wave); }
    SEAM(10);
    if (IN(11)) { const int lane = lane_asm(), tid = wave * 64 + lane; (void)tid;
        const float s1 = wave_sum((INP(13))[lane] * (INP(14))[lane]), s2 = wave_sum((INP(15))[lane] * (INP(16))[lane]);
        const float lam_init = 0.2f, lam = expf(s1) - expf(s2) + lam_init;
        float subln[16], ogn[16];
        { const float* sp_ = INP(17) + (lane & 7) * 16; const float* gp_ = INP(28) + lane * 16;
#pragma unroll
          for (int i = 0; i < 16; ++i) { subln[i] = sp_[i]; ogn[i] = gp_[i]; } }
#define MIX_LOAD(dst, rowA) do { _Pragma("unroll") for (int q = 0; q < 2; ++q) { const int rr_ = (rowA) + q * NGW; const size_t ro = (size_t)(rr_ < M ? rr_ : ((rowA) < M ? (rowA) : gw)) * 1024 + lane * 16; \
                dst[q][0] = *(const v4u*)(p_O32 + ro); dst[q][1] = *(const v4u*)(p_O32 + ro + 8); \
                dst[q][2] = *(const v4u*)(p_O32 + (size_t)M * 1024 + ro); dst[q][3] = *(const v4u*)(p_O32 + (size_t)M * 1024 + ro + 8); \
                dst[q][4] = *(const v4u*)(p_Y2 + ro); dst[q][5] = *(const v4u*)(p_Y2 + ro + 8); } } while (0)
        v4u w[2][6], wn[2][6];
        MIX_LOAD(w, gw);
        for (int row = gw; row < M; row += 2 * NGW) {
            const int r1 = (row + NGW < M) ? row + NGW : row;
            MIX_LOAD(wn, row + 2 * NGW);
            asm volatile("" ::: "memory");
#pragma unroll
            for (int q = 0; q < 2; ++q) { const int r = (q == 0 ? row : r1);
                float a[16], b[16];
#define UNP(dst, lo_, hi_) do { dst[0] = blo(lo_.x); dst[1] = bhi(lo_.x); dst[2] = blo(lo_.y); dst[3] = bhi(lo_.y); dst[4] = blo(lo_.z); dst[5] = bhi(lo_.z); dst[6] = blo(lo_.w); dst[7] = bhi(lo_.w); \
                    dst[8] = blo(hi_.x); dst[9] = bhi(hi_.x); dst[10] = blo(hi_.y); dst[11] = bhi(hi_.y); dst[12] = blo(hi_.z); dst[13] = bhi(hi_.z); dst[14] = blo(hi_.w); dst[15] = bhi(hi_.w); } while (0)
                UNP(a, w[q][0], w[q][1]); UNP(b, w[q][2], w[q][3]);
                float ss = 0.f;
#pragma unroll
                for (int i = 0; i < 16; ++i) { a[i] = a[i] - lam * b[i]; ss += a[i] * a[i]; }
                ss += __shfl_xor(ss, 1); ss += __shfl_xor(ss, 2); ss += __shfl_xor(ss, 4);
                const float rstd = (1.0f - lam_init) / sqrtf(ss * (1.0f / 128.0f) + 1e-6f);
#pragma unroll
                for (int i = 0; i < 16; ++i) a[i] = a[i] * rstd * subln[i];
                pack16(p_MIX + (size_t)r * DMODEL + lane * 16, a);
                UNP(b, w[q][4], w[q][5]); float s3 = 0.f;
#undef UNP
#pragma unroll
                for (int i = 0; i < 16; ++i) s3 += b[i] * b[i];
                const float r2 = 1.0f / sqrtf(wave_sum(s3) * (1.0f / 1024.0f) + 1e-6f);
#pragma unroll
                for (int i = 0; i < 16; ++i) b[i] = b[i] * r2 * ogn[i];
                pack16(p_MIX + (size_t)r * DMODEL + 1024 + lane * 16, b); }
#pragma unroll
            for (int q = 0; q < 2; ++q)
#pragma unroll
                for (int i = 0; i < 6; ++i) w[q][i] = wn[q][i];
        }
#undef MIX_LOAD
    }
    SEAM(11);
    if (IN(12)) { pg8::Gemm g{p_MIX, p_WOUT, DMODEL, DMODEL, DMODEL, 0, 0}; pg8::StaticOrder S; S.init(M, DMODEL, G, bx); pg8::EpiResid<true> Ep{p_out, p_out, DMODEL, p_mod + 5 * DMODEL, p_HB, p_GM + DMODEL, p_SSQ + M};
        pg8::gemm_phase<pg8::EpiResid<true>, pg8::StaticOrder, true, true>(L, g, S, Ep, wave); }
    SEAM(12);
    if (IN(14)) { pg8::Gemm g{p_HB, p_W2U, DMODEL, DMODEL, DMODEL, 0, 0}; pg8::StaticOrder S; S.init(M, NUP, G, bx); pg8::EpiSwiGLU<true> Ep{p_H, FF, p_SSQ + M, p_BV + NIN};
        pg8::gemm_phase<pg8::EpiSwiGLU<true>, pg8::StaticOrder, true, true>(L, g, S, Ep, wave); }
    SEAM(14);
    if (IN(15)) { pg8::Gemm g{p_H, p_W2D, FF, FF, FF, 0, 0}; pg8::StaticOrder S; S.init(M, DMODEL, G, bx); pg8::EpiResid<false> Ep{p_out, p_out, DMODEL, p_mod + 8 * DMODEL, nullptr, nullptr, nullptr};
        pg8::gemm_phase<pg8::EpiResid<false>, pg8::StaticOrder, true, true>(L, g, S, Ep, wave); }
    if (hi - lo == NPH && bx == 0 && wave == 0 && lane_asm() == 0) __hip_atomic_store((unsigned*)p_ws + FB_REL, 2u, __ATOMIC_RELAXED, __HIP_MEMORY_SCOPE_AGENT);
#undef IN
#undef SEAM
#undef p_x
#undef p_cvec
#undef p_pos
#undef p_w_ada
#undef p_b_ada
#undef p_out
#undef p_ws
#undef p_modp
#undef p_mod
#undef p_cid
#undef p_A16
#undef p_CS
#undef p_SSQ
#undef p_BV
#undef p_GM
#undef p_W1U
#undef p_W1D
#undef p_W2U
#undef p_W2D
#undef p_WIN
#undef p_WOUT
#undef p_WGLU
#undef p_BE
#undef p_BY
#undef p_HB
#undef p_H
#undef p_Q
#undef p_K
#undef p_V
#undef p_UGS
#undef p_E
#undef p_O32
#undef p_YG
#undef p_Y2
#undef p_MIX
#undef INP
}

extern "C" void kernel_launch(void* const* d_in, const int* in_sizes, int n_in, void* d_out, int out_size, void* d_ws, size_t ws_size, hipStream_t stream) {
    static int grid = 0;
    if (grid == 0) {
        if (n_in != 34 || in_sizes[0] != M * DMODEL || out_size != M * DMODEL || ws_size < WS_END) { fprintf(stderr, "kernel_launch: unexpected shapes (n_in %d, ws %zu)\n", n_in, ws_size); grid = -1; return; }
        int dev = 0, cus = 0, per_cu = 0;
        (void)hipGetDevice(&dev); (void)hipDeviceGetAttribute(&cus, hipDeviceAttributeMultiprocessorCount, dev);
        (void)hipFuncSetAttribute((const void*)mk_fwd, hipFuncAttributeMaxDynamicSharedMemorySize, LDS_BYTES);
        if (hipOccupancyMaxActiveBlocksPerMultiprocessor(&per_cu, (const void*)mk_fwd, NTHR, LDS_BYTES) != hipSuccess || per_cu < 1) per_cu = 1;
        (void)hipGetLastError();
        if (cus <= 0) cus = 256;
        grid = cus * per_cu; if (grid > 256) grid = 256;
    }
    if (grid < 0) return;
    Args a{};
    for (int i = 0; i < 34; ++i) a.in[i] = d_in[i];
    a.out = (float*)d_out; a.ws = (unsigned char*)d_ws;
#if MK_N_LAUNCHES == 1
    a.ph_lo = 0; a.ph_hi = NPH;
    void* kargs[] = {&a};
    hipError_t e = hipLaunchCooperativeKernel((const void*)mk_fwd, dim3(grid), dim3(NTHR), kargs, LDS_BYTES, stream);
    if (e != hipSuccess) {
        fprintf(stderr, "cooperative launch failed: %s (grid %d); falling back to one launch per phase\n", hipGetErrorString(e), grid);
        (void)hipGetLastError();
        for (int ph = 0; ph < NPH; ++ph) { a.ph_lo = ph; a.ph_hi = ph + 1; hipLaunchKernelGGL(mk_fwd, dim3(grid), dim3(NTHR), LDS_BYTES, stream, a); }
    }
#ifdef PROBE_PHASES
    { const int pp[] = {PROBE_PHASES}; for (int ph : pp) { a.ph_lo = ph; a.ph_hi = ph + 1; hipLaunchKernelGGL(mk_fwd, dim3(grid), dim3(NTHR), LDS_BYTES, stream, a); } }
#endif
#else
    for (int ph = 0; ph < NPH; ++ph) { a.ph_lo = ph; a.ph_hi = ph + 1; hipLaunchKernelGGL(mk_fwd, dim3(grid), dim3(NTHR), LDS_BYTES, stream, a); }
#endif
}
```

```cpp
#include <hip/hip_runtime.h>
#include <hip/hip_cooperative_groups.h>
#include <hip/hip_bf16.h>
#include <cstdio>
#include <cstdint>
#include <cmath>
namespace cg = cooperative_groups;
__device__ __forceinline__ int lane_asm() { int l; asm volatile("v_mbcnt_lo_u32_b32 %0, -1, 0\n\tv_mbcnt_hi_u32_b32 %0, -1, %0" : "=v"(l)); return l; }

namespace pg8 {
#define PG8_LAS __attribute__((address_space(3)))
typedef unsigned short bf16_t;
typedef short bf16x8 __attribute__((ext_vector_type(8)));
typedef float f32x4 __attribute__((ext_vector_type(4)));
typedef unsigned u32x4 __attribute__((ext_vector_type(4)));
constexpr int BM = 256, BK = 64, HALF = 128, HTB = HALF * BK * 2  , STAGE_BYTES = 8 * HTB, NXCD = 8, WGM = 8;

__host__ __device__ __forceinline__ int lds_byte(int r, int c) { const int st = (r >> 4) * 2 + (c >> 5), rr = r & 15, cc = c & 31, ob = rr * 64 + cc * 2; return st * 1024 + (ob ^ (((ob >> 9) & 1) << 5)); }
__host__ __device__ __forceinline__ void stage_rc(int b, int& R, int& C) { const int st = b / 1024, sb = b % 1024, swz = sb ^ (((sb >> 9) & 1) << 5); R = (st >> 1) * 16 + swz / 64; C = (st & 1) * 32 + (swz % 64) / 2; }
__host__ __device__ __forceinline__ int perm32(int rho) { const int n = rho >> 4, i = rho & 15; return 8 * (i >> 2) + 4 * n + (i & 3); }

struct Unit { int pm, pn, pz; };
struct Gemm { const bf16_t* A; const bf16_t* Bt; int lda, ldb, K; size_t azs, bzs; };

struct StaticOrder {
    int nM, nN, nwg, G, c;
    __host__ __device__ void init(int M, int N, int G_, int c_) { nM = M / BM; nN = N / BM; nwg = nM * nN; G = G_; c = c_; }
    __host__ __device__ bool next(int i, Unit& u) const {
        const long L = (long)i * G + c; if (L >= nwg) return false;
        int wgid = (int)L; { const int q = nwg / NXCD, r = nwg % NXCD, xcd = wgid % NXCD, off = wgid / NXCD; wgid = (xcd < r ? xcd * (q + 1) : r * (q + 1) + (xcd - r) * q) + off; }
        const int nig = WGM * nN, gid = wgid / nig, fm = gid * WGM, gsz = (nM - fm) < WGM ? (nM - fm) : WGM;
        u.pm = fm + ((wgid % nig) % gsz); u.pn = (wgid % nig) / gsz; u.pz = 0; return true;
    }
};
struct BatchOrder {
    int nM, nun, G, c;
    __host__ __device__ void init(int nM_, int nZ, int G_, int c_) { nM = nM_; nun = nM_ * nZ; G = G_; c = c_; }
    __host__ __device__ bool next(int i, Unit& u) const { const long L = (long)i * G + c; if (L >= nun) return false; u.pz = (int)L / nM; u.pm = (int)L % nM; u.pn = 0; return true; }
};

__device__ __forceinline__ unsigned cvt_pk_bf16(float lo, float hi) { unsigned r; asm volatile("v_cvt_pk_bf16_f32 %0, %1, %2" : "=v"(r) : "v"(lo), "v"(hi)); return r; }
__device__ __forceinline__ float bf_lo(unsigned w) { return __uint_as_float(w << 16); }
__device__ __forceinline__ float bf_hi(unsigned w) { return __uint_as_float(w & 0xffff0000u); }
__device__ __forceinline__ float sigmoid_f(float a) { return __builtin_amdgcn_rcpf(1.0f + __builtin_amdgcn_exp2f(-1.4426950408889634f * a)); }
__device__ __forceinline__ float silu_f(float a) { return a * sigmoid_f(a); }
__device__ __forceinline__ float gelu_tanh_f(float v) {
    const float z = 0.7978845608028654f * (v + 0.044715f * v * v * v); return v * sigmoid_f(2.0f * z);
}
__device__ __forceinline__ u32x4 pack8(const f32x4& v0, const f32x4& v1) { u32x4 w; w.x = cvt_pk_bf16(v0[0], v0[1]); w.y = cvt_pk_bf16(v0[2], v0[3]); w.z = cvt_pk_bf16(v1[0], v1[1]); w.w = cvt_pk_bf16(v1[2], v1[3]); return w; }

__device__ __forceinline__ float rstd_from_ssq(const unsigned long long* ssq, int row) {
    return 1.0f / sqrtf((float)ssq[row] * (1.0f / 16777216.0f) * (1.0f / 2048.0f) + 1e-6f);
}
typedef float f32x2 __attribute__((ext_vector_type(2)));
__device__ __forceinline__ f32x4 swiglu4(const f32x4 a, const f32x4 b) {
    const f32x4 t = a * (-1.4426950408889634f); f32x4 e;
#pragma unroll
    for (int k = 0; k < 4; ++k) e[k] = __builtin_amdgcn_exp2f(t[k]);
    e = e + 1.0f;
#pragma unroll
    for (int k = 0; k < 4; ++k) e[k] = __builtin_amdgcn_rcpf(e[k]);
    return (a * e) * b;
}
template <bool DEFER> struct EpiSwiGLU {
    static constexpr bool PERM = true;
    bf16_t* O; int ldc; const unsigned long long* ssq; const float* bv;
    __device__ __forceinline__ void operator()(const f32x4 (&acc)[2][2][4][2], const Unit& u, int wr, int wc, int fr_, int fq_) const {
        const int l_ = lane_asm(); const int fr = l_ & 15, fq = l_ >> 4; (void)fr_; (void)fq_;
        const int row0 = u.pm * BM + wr * 64 + fr, col0 = u.pn * HALF + wc * 32 + 8 * fq;
        f32x4 ba0 = {0.f, 0.f, 0.f, 0.f}, ba1 = ba0, bb0 = ba0, bb1 = ba0;
        if constexpr (DEFER) { const float* bp = bv + u.pn * BM + wc * 32 + 8 * fq; ba0 = *(const f32x4*)bp; ba1 = *(const f32x4*)(bp + 4); bb0 = *(const f32x4*)(bp + HALF); bb1 = *(const f32x4*)(bp + HALF + 4); }
        float rsv[8];
        if constexpr (DEFER) {
#pragma unroll
            for (int i = 0; i < 8; ++i) rsv[i] = rstd_from_ssq(ssq, row0 + (i >> 2) * HALF + (i & 3) * 16);
            asm volatile("" ::: "memory"); }
#pragma unroll
        for (int ai = 0; ai < 2; ++ai)
#pragma unroll
            for (int m = 0; m < 4; ++m) { const int row = row0 + ai * HALF + m * 16; bf16_t* rowp = O + (size_t)row * ldc + col0;
                f32x4 v0, v1;
                if constexpr (DEFER) { const float rs = rsv[ai * 4 + m];
                    v0 = swiglu4(acc[ai][0][m][0] * rs + ba0, acc[ai][1][m][0] * rs + bb0); v1 = swiglu4(acc[ai][0][m][1] * rs + ba1, acc[ai][1][m][1] * rs + bb1); }
                else { v0 = swiglu4(acc[ai][0][m][0], acc[ai][1][m][0]); v1 = swiglu4(acc[ai][0][m][1], acc[ai][1][m][1]); }
                *(u32x4*)rowp = pack8(v0, v1); }
    }
};
template <bool EMIT> struct EpiResid {
    static constexpr bool PERM = false;
    const float* base; float* out; int ldc; const float* gate;
    bf16_t* A2; const float* gmv; unsigned long long* ssq;
    __device__ __forceinline__ void operator()(const f32x4 (&acc)[2][2][4][2], const Unit& u, int wr, int wc, int fr_, int fq_) const {
        const int l_ = lane_asm(); const int fr = l_ & 15, fq = l_ >> 4; (void)fr_; (void)fq_;
        const int row0 = u.pm * BM + wr * 64 + fr, col0 = u.pn * BM + wc * 32 + 4 * fq;
        f32x4 gv[2][2], gm[2][2];
#pragma unroll
        for (int bj = 0; bj < 2; ++bj)
#pragma unroll
            for (int n = 0; n < 2; ++n) { gv[bj][n] = *(const f32x4*)(gate + col0 + bj * HALF + n * 16);
                if constexpr (EMIT) gm[bj][n] = *(const f32x4*)(gmv + col0 + bj * HALF + n * 16); else gm[bj][n] = gv[bj][n]; }
#pragma unroll
        for (int ai = 0; ai < 2; ++ai)
#pragma unroll
        for (int mh = 0; mh < 2; ++mh) {
            f32x4 bs[2][2][2];
#pragma unroll
            for (int m = 0; m < 2; ++m) { const size_t off = (size_t)(row0 + ai * HALF + (2 * mh + m) * 16) * ldc + col0;
#pragma unroll
                for (int bj = 0; bj < 2; ++bj)
#pragma unroll
                    for (int n = 0; n < 2; ++n) bs[m][bj][n] = *(const f32x4*)(base + off + bj * HALF + n * 16); }
            asm volatile("" ::: "memory");
#pragma unroll
            for (int m = 0; m < 2; ++m) { const int row = row0 + ai * HALF + (2 * mh + m) * 16; const size_t off = (size_t)row * ldc + col0; float ss = 0.f;
#pragma unroll
                for (int bj = 0; bj < 2; ++bj)
#pragma unroll
                    for (int n = 0; n < 2; ++n) { const f32x4 o = bs[m][bj][n] + gv[bj][n] * acc[ai][bj][2 * mh + m][n]; *(f32x4*)(out + off + bj * HALF + n * 16) = o;
                        if constexpr (EMIT) { ss += (o[0] * o[0] + o[1] * o[1]) + (o[2] * o[2] + o[3] * o[3]); const f32x4 y = o * gm[bj][n];
                            typedef unsigned u32x2_t __attribute__((ext_vector_type(2))); u32x2_t w; w.x = cvt_pk_bf16(y[0], y[1]); w.y = cvt_pk_bf16(y[2], y[3]); *(u32x2_t*)(A2 + off + bj * HALF + n * 16) = w; } }
                if constexpr (EMIT) { ss += __shfl_xor(ss, 16); ss += __shfl_xor(ss, 32); if (fq == 0) atomicAdd(ssq + row, (unsigned long long)(ss * 16777216.0f)); } }
            asm volatile("" ::: "memory");
        }
    }
};
struct EpiQKVU {
    static constexpr bool PERM = true;
    bf16_t* Q; size_t qkv_stride; bf16_t* U; const float* qn; const float* kn; const float* cs; float c2; const unsigned long long* ssq; const float* bv;
    __device__ __forceinline__ void operator()(const f32x4 (&acc)[2][2][4][2], const Unit& u, int wr, int wc, int fr_, int fq_) const {
        const int l_ = lane_asm(); const int fr = l_ & 15, fq = l_ >> 4; (void)fr_; (void)fq_;
        const int row0 = u.pm * BM + wr * 64 + fr, t = u.pn >> 2;
        float rsv[8];
#pragma unroll
        for (int i = 0; i < 8; ++i) rsv[i] = rstd_from_ssq(ssq, row0 + (i >> 2) * HALF + (i & 3) * 16);
        asm volatile("" ::: "memory");
        if (t < 2) {
            f32x4 g[2][2];
#pragma unroll
            for (int bj = 0; bj < 2; ++bj)
#pragma unroll
                for (int n = 0; n < 2; ++n) { const f32x4 a = *(const f32x4*)(qn + bj * 32 + 8 * fq + 4 * n), b = *(const f32x4*)(kn + bj * 32 + 8 * fq + 4 * n); g[bj][n] = t == 0 ? a : b; }
            const float sc = t == 0 ? c2 : 1.0f;
            const float* bp = bv + u.pn * BM + wc * 32 + 8 * fq; const f32x4 b00 = *(const f32x4*)bp, b01 = *(const f32x4*)(bp + 4), b10 = *(const f32x4*)(bp + HALF), b11 = *(const f32x4*)(bp + HALF + 4);
            const unsigned long long* sp = ssq + row0;
            bf16_t* rp = Q + (size_t)t * qkv_stride + (size_t)row0 * 1024 + ((u.pn & 3) * 4 + wc) * 64 + 8 * fq;
            const float* cp = cs + (size_t)row0 * 16;
#pragma unroll
            for (int ai = 0; ai < 2; ++ai)
#pragma unroll
                for (int m = 0; m < 4; ++m) {
                    asm volatile("" : "+v"(rp), "+v"(cp), "+v"(sp));
                    const float rs = rsv[ai * 4 + m];
                    f32x4 v00 = acc[ai][0][m][0] * rs + b00, v01 = acc[ai][0][m][1] * rs + b01, v10 = acc[ai][1][m][0] * rs + b10, v11 = acc[ai][1][m][1] * rs + b11;
                    float ss = 0.f;
#pragma unroll
                    for (int k = 0; k < 4; ++k) ss += v00[k] * v00[k] + v01[k] * v01[k] + v10[k] * v10[k] + v11[k] * v11[k];
                    ss += __shfl_xor(ss, 16); ss += __shfl_xor(ss, 32);
                    const float rstd = 1.0f / sqrtf(ss * (1.0f / 64.0f) + 1e-6f);
                    v00 = v00 * rstd * g[0][0]; v01 = v01 * rstd * g[0][1]; v10 = v10 * rstd * g[1][0]; v11 = v11 * rstd * g[1][1];
                    f32x4 p0, p1;
#pragma unroll
                    for (int k = 0; k < 4; ++k) { p0[k] = __shfl_xor(v00[k], 16); p1[k] = __shfl_xor(v01[k], 16); }
                    const f32x4 c0 = *(const f32x4*)(cp), c1 = *(const f32x4*)(cp + 4), s0 = *(const f32x4*)(cp + 8), s1 = *(const f32x4*)(cp + 12);
                    if (fq < 2) {
                        if (fq == 0) { v00 = v00 * c0 - p0 * s0; v01 = v01 * c1 - p1 * s1; } else { v00 = p0 * s0 + v00 * c0; v01 = p1 * s1 + v01 * c1; } }
                    v00 = v00 * sc; v01 = v01 * sc; v10 = v10 * sc; v11 = v11 * sc;
                    *(u32x4*)rp = pack8(v00, v01); *(u32x4*)(rp + 32) = pack8(v10, v11);
                    const int adv = (m == 3) ? (128 - 48) : 16; rp += (size_t)adv * 1024; cp += (size_t)adv * 16; sp += adv; }
            return;
        }
        const int col0 = (u.pn & 3) * BM + wc * 32 + 8 * fq;
        bf16_t* base = Q + (size_t)2 * qkv_stride;
        const float* bp2 = bv + u.pn * BM + wc * 32 + 8 * fq;
        const f32x4 bq[2][2] = {{*(const f32x4*)(bp2), *(const f32x4*)(bp2 + 4)}, {*(const f32x4*)(bp2 + HALF), *(const f32x4*)(bp2 + HALF + 4)}};
        asm volatile("" ::: "memory");
#pragma unroll
        for (int ai = 0; ai < 2; ++ai)
#pragma unroll
            for (int m = 0; m < 4; ++m) { const int row = row0 + ai * HALF + m * 16;
#pragma unroll
                for (int bj = 0; bj < 2; ++bj) { const int col = col0 + bj * HALF; const float rs = rsv[ai * 4 + m];
                    const u32x4 w = pack8(acc[ai][bj][m][0] * rs + bq[bj][0], acc[ai][bj][m][1] * rs + bq[bj][1]);
                    if (t < 3) *(u32x4*)(base + (size_t)row * 1024 + col) = w;
                    else *(u32x4*)(U + ((size_t)((row >> 4) * 64 + (col >> 4)) * 384 + (row & 15) * 16 + (col & 15))) = w; } }
    }
};
struct EpiF32 {
    static constexpr bool PERM = false;
    float* out; int ldc;
    __device__ __forceinline__ void operator()(const f32x4 (&acc)[2][2][4][2], const Unit& u, int wr, int wc, int fr, int fq) const {
        const int row0 = u.pm * BM + wr * 64 + fr, col0 = u.pz * BM + wc * 32 + 4 * fq;
#pragma unroll
        for (int ai = 0; ai < 2; ++ai)
#pragma unroll
            for (int m = 0; m < 4; ++m) { const size_t off = (size_t)(row0 + ai * HALF + m * 16) * ldc + col0;
#pragma unroll
                for (int bj = 0; bj < 2; ++bj)
#pragma unroll
                    for (int n = 0; n < 2; ++n) *(f32x4*)(out + off + bj * HALF + n * 16) = acc[ai][bj][m][n]; }
    }
};
struct EpiSsmY {
    static constexpr bool PERM = true;
    const bf16_t* U; const float* dskip; bf16_t* YG;
    __device__ __forceinline__ void operator()(const f32x4 (&acc)[2][2][4][2], const Unit& u, int wr, int wc, int fr_, int fq_) const {
        const int l_ = lane_asm(); const int fr = l_ & 15, fq = l_ >> 4; (void)fr_; (void)fq_;
        const int row0 = u.pm * BM + wr * 64 + fr, g = u.pz, col0 = wc * 32 + 8 * fq, co0 = col0 & 15;
        const f32x4 d0 = *(const f32x4*)(dskip + g * 16 + co0), d1 = *(const f32x4*)(dskip + g * 16 + co0 + 4);
        const bf16_t* up = U + ((size_t)(row0 * 64 + g) * 384 + col0);
        bf16_t* yp = YG + ((size_t)row0 * 16 + (col0 >> 4)) * 1024 + g * 16 + co0;
        u32x4 uwv[2][2];
#pragma unroll
        for (int ai = 0; ai < 2; ++ai)
#pragma unroll
            for (int m = 0; m < 4; ++m) {
                asm volatile("" : "+v"(up), "+v"(yp));
                if ((m & 1) == 0) {
                    uwv[0][0] = *(const u32x4*)(up); uwv[0][1] = *(const u32x4*)(up + 128);
                    uwv[1][0] = *(const u32x4*)(up + (size_t)16 * 64 * 384); uwv[1][1] = *(const u32x4*)(up + (size_t)16 * 64 * 384 + 128);
                    asm volatile("" ::: "memory"); }
#pragma unroll
                for (int bj = 0; bj < 2; ++bj) {
                    const u32x4 uw = uwv[m & 1][bj];
                    f32x4 v0 = acc[ai][bj][m][0], v1 = acc[ai][bj][m][1];
                    v0[0] += d0[0] * bf_lo(uw.x); v0[1] += d0[1] * bf_hi(uw.x); v0[2] += d0[2] * bf_lo(uw.y); v0[3] += d0[3] * bf_hi(uw.y);
                    v1[0] += d1[0] * bf_lo(uw.z); v1[1] += d1[1] * bf_hi(uw.z); v1[2] += d1[2] * bf_lo(uw.w); v1[3] += d1[3] * bf_hi(uw.w);
#pragma unroll
                    for (int k = 0; k < 4; ++k) { v0[k] = gelu_tanh_f(v0[k]); v1[k] = gelu_tanh_f(v1[k]); }
                    *(u32x4*)(yp + bj * 8 * 1024) = pack8(v0, v1); }
                const int adv = (m == 3) ? (128 - 48) : 16;
                up += (size_t)adv * 64 * 384; yp += (size_t)adv * 16 * 1024; }
    }
};
struct EpiGlu {
    static constexpr bool PERM = true;
    const bf16_t* YG; const float* bias; bf16_t* Y2;
    __device__ __forceinline__ void operator()(const f32x4 (&acc)[2][2][4][2], const Unit& u, int wr, int wc, int fr, int fq) const {
        const int row0 = u.pm * BM + wr * 64 + fr, col0 = u.pn * BM + wc * 32 + 8 * fq;
#pragma unroll
        for (int bj = 0; bj < 2; ++bj) { const int col = col0 + bj * HALF;
            const f32x4 b0 = *(const f32x4*)(bias + col), b1 = *(const f32x4*)(bias + col + 4);
            u32x4 ywv[8];
#pragma unroll
            for (int i = 0; i < 8; ++i) ywv[i] = *(const u32x4*)(YG + (size_t)(row0 + (i >> 2) * HALF + (i & 3) * 16) * 1024 + col);
            asm volatile("" ::: "memory");
#pragma unroll
            for (int ai = 0; ai < 2; ++ai)
#pragma unroll
                for (int m = 0; m < 4; ++m) { const size_t off = (size_t)(row0 + ai * HALF + m * 16) * 1024 + col;
                    const u32x4 yw = ywv[ai * 4 + m];
                    f32x4 v0 = acc[ai][bj][m][0] + b0, v1 = acc[ai][bj][m][1] + b1;
                    v0[0] = bf_lo(yw.x) * sigmoid_f(v0[0]); v0[1] = bf_hi(yw.x) * sigmoid_f(v0[1]); v0[2] = bf_lo(yw.y) * sigmoid_f(v0[2]); v0[3] = bf_hi(yw.y) * sigmoid_f(v0[3]);
                    v1[0] = bf_lo(yw.z) * sigmoid_f(v1[0]); v1[1] = bf_hi(yw.z) * sigmoid_f(v1[1]); v1[2] = bf_lo(yw.w) * sigmoid_f(v1[2]); v1[3] = bf_hi(yw.w) * sigmoid_f(v1[3]);
                    *(u32x4*)(Y2 + off) = pack8(v0, v1); }
            asm volatile("" ::: "memory"); }
    }
};

template <class Epi, class Sched, bool ALIGN_EPI = false, bool SP2 = false>
__device__ __forceinline__ void gemm_phase(PG8_LAS unsigned char* lds, const Gemm g, const Sched& S, const Epi& E, const int wid) {
    const int lane = lane_asm(), tid = wid * 64 + lane, wr = wid >> 2, wc = wid & 3, fr = lane & 15, fq = lane >> 4;
    const int K = g.K, nt = K / BK;
    unsigned voffA[2], voffB[2];
#pragma unroll
    for (int i = 0; i < 2; ++i) { int R, C; stage_rc(tid * 16 + i * 8192, R, C); const int Rb = Epi::PERM ? ((R & ~31) + perm32(R & 31)) : R;
        voffA[i] = (unsigned)(R * g.lda + C) * 2u; voffB[i] = (unsigned)(Rb * g.ldb + C) * 2u; }
    const size_t kstep = (size_t)(BK * 2);
    const size_t hsA = (size_t)HALF * g.lda * 2, hsB = (size_t)HALF * g.ldb * 2;
#define PG8_APTR(u) ((const char*)g.A + ((size_t)(u).pz * g.azs + (size_t)(u).pm * BM * g.lda) * 2)
#define PG8_BPTR(u) ((const char*)g.Bt + ((size_t)(u).pz * g.bzs + (size_t)(u).pn * BM * g.ldb) * 2)
    const unsigned ldsw = (unsigned)wid * 1024u;
    const int aoff = lds_byte(wr * 64 + fr, fq * 8), boff = lds_byte(wc * 32 + fr, fq * 8);
#define PG8_SA(b, h) (((b) * 2 + (h)) * HTB)
#define PG8_SB(b, h) ((4 + (b) * 2 + (h)) * HTB)
#define PG8_STAGE(bufoff, gbase, voff) do { _Pragma("unroll") for (int _i = 0; _i < 2; ++_i) \
        __builtin_amdgcn_global_load_lds((const unsigned*)((const char*)(gbase) + (voff)[_i]), (PG8_LAS unsigned*)(lds + (bufoff) + ldsw + _i * 8192), 16, 0, 0); } while (0)
#define PG8_LDA(dst, b, h) do { _Pragma("unroll") for (int m = 0; m < 4; ++m) _Pragma("unroll") for (int k = 0; k < 2; ++k) dst[m][k] = *(const PG8_LAS bf16x8*)(lds + PG8_SA(b, h) + aoff + m * 2048 + k * 1024); } while (0)
#define PG8_LDB(dst, b, h) do { _Pragma("unroll") for (int n = 0; n < 2; ++n) _Pragma("unroll") for (int k = 0; k < 2; ++k) dst[n][k] = *(const PG8_LAS bf16x8*)(lds + PG8_SB(b, h) + boff + n * 2048 + k * 1024); } while (0)
#define PG8_MMA(ai, bj, At, Bt) do { __builtin_amdgcn_s_setprio(1); _Pragma("unroll") for (int m = 0; m < 4; ++m) _Pragma("unroll") for (int n = 0; n < 2; ++n) _Pragma("unroll") for (int k = 0; k < 2; ++k) \
        acc[ai][bj][m][n] = __builtin_amdgcn_mfma_f32_16x16x32_bf16(Bt[n][k], At[m][k], acc[ai][bj][m][n], 0, 0, 0); __builtin_amdgcn_s_setprio(0); } while (0)
#define PG8_WAIT_V(n) asm volatile("s_waitcnt vmcnt(" #n ")" ::: "memory")
#define PG8_WAIT_L(n) asm volatile("s_waitcnt lgkmcnt(" #n ")" ::: "memory")
#define PG8_BAR __builtin_amdgcn_s_barrier()
#define PG8_SCHED __builtin_amdgcn_sched_barrier(0)
    Unit cur, nxt; int ui = 0;
    if (!S.next(0, cur)) return;
    f32x4 acc[2][2][4][2];
#pragma unroll
    for (int a = 0; a < 2; ++a)
#pragma unroll
        for (int b = 0; b < 2; ++b)
#pragma unroll
            for (int m = 0; m < 4; ++m)
#pragma unroll
                for (int n = 0; n < 2; ++n) acc[a][b][m][n] = (f32x4){0.f, 0.f, 0.f, 0.f};
    bf16x8 At[4][2], B0[2][2], B1[2][2];
    const char* cA = PG8_APTR(cur); const char* cB = PG8_BPTR(cur);
    if constexpr (SP2) {
        PG8_STAGE(PG8_SB(0, 0), cB, voffB); PG8_STAGE(PG8_SB(0, 1), cB + hsB, voffB); PG8_STAGE(PG8_SA(0, 0), cA, voffA); PG8_STAGE(PG8_SA(0, 1), cA + hsA, voffA);
        if (wr == 1) PG8_BAR;
        PG8_WAIT_V(2); PG8_BAR;
        PG8_STAGE(PG8_SB(1, 0), cB + kstep, voffB); PG8_STAGE(PG8_SA(1, 0), cA + kstep, voffA); PG8_STAGE(PG8_SB(1, 1), cB + hsB + kstep, voffB);
        PG8_WAIT_V(6); PG8_BAR;
    } else {
        PG8_STAGE(PG8_SB(0, 0), cB, voffB); PG8_STAGE(PG8_SA(0, 0), cA, voffA); PG8_STAGE(PG8_SB(0, 1), cB + hsB, voffB); PG8_STAGE(PG8_SA(0, 1), cA + hsA, voffA);
        if (wr == 1) PG8_BAR;
        PG8_WAIT_V(4); PG8_BAR;
        PG8_STAGE(PG8_SB(1, 0), cB + kstep, voffB); PG8_STAGE(PG8_SA(1, 0), cA + kstep, voffA); PG8_STAGE(PG8_SB(1, 1), cB + hsB + kstep, voffB);
        PG8_WAIT_V(6); PG8_BAR;
    }
    for (;;) {
        const bool has_next = S.next(ui + 1, nxt);
        const char* nA = has_next ? PG8_APTR(nxt) : cA; const char* nB = has_next ? PG8_BPTR(nxt) : cB;
        for (int t = 0; t < nt; t += 2) {
            const bool last = (t == nt - 2);
            const char* a1 = cA + (size_t)(t + 1) * kstep;
            const char* a2 = last ? nA : cA + (size_t)(t + 2) * kstep; const char* b2 = last ? nB : cB + (size_t)(t + 2) * kstep;
            const char* a3 = a2 + kstep; const char* b3 = b2 + kstep;

            if constexpr (SP2) {
            PG8_LDB(B0, 0, 0); PG8_LDB(B1, 0, 1); PG8_SCHED; PG8_LDA(At, 0, 0); PG8_STAGE(PG8_SA(1, 1), a1 + hsA, voffA);
            PG8_WAIT_V(8); PG8_WAIT_L(0); PG8_BAR; PG8_MMA(0, 0, At, B0); PG8_MMA(0, 1, At, B1); PG8_BAR; PG8_SCHED;
            PG8_LDA(At, 0, 1); PG8_STAGE(PG8_SB(0, 0), b2, voffB); PG8_STAGE(PG8_SB(0, 1), b2 + hsB, voffB); PG8_STAGE(PG8_SA(0, 0), a2, voffA);
            PG8_WAIT_V(8); PG8_WAIT_L(0); PG8_BAR; PG8_MMA(1, 0, At, B0); PG8_MMA(1, 1, At, B1); PG8_BAR; PG8_SCHED;
            PG8_LDB(B0, 1, 0); PG8_LDB(B1, 1, 1); PG8_SCHED; PG8_LDA(At, 1, 0); PG8_STAGE(PG8_SA(0, 1), a2 + hsA, voffA);
            PG8_WAIT_V(8); PG8_WAIT_L(0); PG8_BAR; PG8_MMA(0, 0, At, B0); PG8_MMA(0, 1, At, B1); PG8_BAR; PG8_SCHED;
            PG8_LDA(At, 1, 1); PG8_STAGE(PG8_SB(1, 0), b3, voffB); PG8_STAGE(PG8_SB(1, 1), b3 + hsB, voffB); PG8_STAGE(PG8_SA(1, 0), a3, voffA);
            PG8_WAIT_V(8); PG8_WAIT_L(0); PG8_BAR; PG8_MMA(1, 0, At, B0); PG8_MMA(1, 1, At, B1); PG8_BAR; PG8_SCHED;
            } else {
            PG8_LDB(B0, 0, 0); PG8_SCHED; PG8_LDA(At, 0, 0); PG8_STAGE(PG8_SA(1, 1), a1 + hsA, voffA);
            PG8_WAIT_L(8); PG8_BAR; PG8_WAIT_L(0); PG8_MMA(0, 0, At, B0); PG8_BAR; PG8_SCHED;
            PG8_LDB(B1, 0, 1); PG8_STAGE(PG8_SB(0, 0), b2, voffB);
            PG8_BAR; PG8_WAIT_L(0); PG8_MMA(0, 1, At, B1); PG8_BAR;
            PG8_LDA(At, 0, 1); PG8_STAGE(PG8_SA(0, 0), a2, voffA);
            PG8_BAR; PG8_WAIT_L(0); PG8_MMA(1, 0, At, B0); PG8_BAR; PG8_SCHED;
            PG8_STAGE(PG8_SB(0, 1), b2 + hsB, voffB);
            PG8_WAIT_V(6); PG8_BAR; PG8_MMA(1, 1, At, B1); PG8_BAR;
            PG8_LDB(B0, 1, 0); PG8_SCHED; PG8_LDA(At, 1, 0); PG8_STAGE(PG8_SA(0, 1), a2 + hsA, voffA);
            PG8_WAIT_L(8); PG8_BAR; PG8_WAIT_L(0); PG8_MMA(0, 0, At, B0); PG8_BAR; PG8_SCHED;
            PG8_LDB(B1, 1, 1); PG8_STAGE(PG8_SB(1, 0), b3, voffB);
            PG8_BAR; PG8_WAIT_L(0); PG8_MMA(0, 1, At, B1); PG8_BAR;
            PG8_LDA(At, 1, 1); PG8_STAGE(PG8_SA(1, 0), a3, voffA);
            PG8_BAR; PG8_WAIT_L(0); PG8_MMA(1, 0, At, B0); PG8_BAR; PG8_SCHED;
            PG8_STAGE(PG8_SB(1, 1), b3 + hsB, voffB);
            PG8_WAIT_V(6); PG8_BAR; PG8_MMA(1, 1, At, B1); PG8_BAR;
            }
        }
        if constexpr (ALIGN_EPI) { if (wr == 0) PG8_BAR; }
        E(acc, cur, wr, wc, fr, fq);
        if (!has_next) break;
#pragma unroll
        for (int a = 0; a < 2; ++a)
#pragma unroll
            for (int b = 0; b < 2; ++b)
#pragma unroll
                for (int m = 0; m < 4; ++m)
#pragma unroll
                    for (int n = 0; n < 2; ++n) acc[a][b][m][n] = (f32x4){0.f, 0.f, 0.f, 0.f};
        cur = nxt; cA = nA; cB = nB; ++ui;
        if constexpr (ALIGN_EPI) { if (wr == 1) PG8_BAR; }
    }
    PG8_WAIT_V(0);
    if constexpr (!ALIGN_EPI) { if (wr == 0) PG8_BAR; }
    PG8_BAR;
#undef PG8_SA
#undef PG8_SB
#undef PG8_STAGE
#undef PG8_LDA
#undef PG8_LDB
#undef PG8_MMA
#undef PG8_WAIT_V
#undef PG8_WAIT_L
#undef PG8_BAR
#undef PG8_SCHED
#undef PG8_APTR
#undef PG8_BPTR
}
}
namespace attn_body {
using bf16=__hip_bfloat16;
using bf16x8=__attribute__((ext_vector_type(8)))short;
using s16x4=__attribute__((ext_vector_type(4)))short;
using f32x16=__attribute__((ext_vector_type(16)))float;
using u32x4=__attribute__((ext_vector_type(4)))unsigned;
constexpr int SEQ=16384,D=64,DM=1024;
constexpr int NW=8,QBLK=32,QB=QBLK*NW,KVBLK=64,NQB=SEQ/QB;
constexpr int ATTN_PITCH=DM, ATTN_UNIT_ROWS=QB;
__device__ __forceinline__ int crow(int r,int hi){return (r&3)+8*(r>>2)+4*hi;}
#define SBAR() __builtin_amdgcn_sched_barrier(0)
typedef __attribute__((address_space(3))) const int* lds_iptr;
__device__ __forceinline__ void cmask(f32x16&p0,f32x16&p1,lds_iptr ck,int qc,int hi){
  const float NEG=-INFINITY;
  #pragma unroll
  for(int r=0;r<16;++r){int kv=4*hi+(r&3)+8*(r>>2); if(ck[kv]>qc)p0[r]=NEG; if(ck[kv+32]>qc)p1[r]=NEG;}
}

constexpr int NSLOT=3, SLOTB=8192;
constexpr int LDS_K=0, LDS_V=NSLOT*SLOTB, LDS_WS=3*NSLOT*SLOTB  , LDS_OST=LDS_WS+NW*64*4, LDS_CID=LDS_OST+NW*4096, LDS_BYTES=LDS_CID+1024;
constexpr float C2=0.125f*1.4426950408889634f;
__device__ __forceinline__ void glds16(const void*gsrc,unsigned lds_dst){unsigned keep;
  asm volatile("s_mov_b32 %0, m0\n\ts_mov_b32 m0, %2\n\ts_nop 0\n\tglobal_load_lds_dwordx4 %1, off\n\ts_mov_b32 m0, %0":"=&s"(keep):"v"(gsrc),"s"(lds_dst):"memory");}
__device__ __forceinline__ float max3f(float a,float b,float c){float r;asm("v_max3_f32 %0, %1, %2, %3":"=v"(r):"v"(a),"v"(b),"v"(c));return r;}
__device__ __forceinline__ float max2f(float a,float b){float r;asm("v_max_f32_e32 %0, %1, %2":"=v"(r):"v"(a),"v"(b));return r;}
__device__ __forceinline__ float fadd_s(float a,float b){float r;asm("v_add_f32_e32 %0, %1, %2":"=v"(r):"v"(a),"v"(b));return r;}
__device__ __forceinline__ float fsub_s(float a,float b){float r;asm("v_sub_f32_e32 %0, %1, %2":"=v"(r):"v"(a),"v"(b));return r;}
typedef float f32x2_t __attribute__((ext_vector_type(2))); typedef __bf16 bf16x2_t __attribute__((ext_vector_type(2)));
__device__ __forceinline__ unsigned cvtpk_s(float lo,float hi){f32x2_t v={lo,hi};bf16x2_t b=__builtin_convertvector(v,bf16x2_t);return __builtin_bit_cast(unsigned,b);}
#define WAIT_BAR(N) asm volatile("s_waitcnt vmcnt(" #N ") lgkmcnt(0)\n\ts_barrier":::"memory")

__device__ __forceinline__ void qkt(f32x16&p0,f32x16&p1,const char*Kslot,const bf16x8*qr,int r32,int hi){ const f32x16 negm=f32x16{};
  const char*kb=Kslot+hi*1024+r32*16;
  #pragma unroll
  for(int d0=0;d0<4;++d0){
    const bf16x8 b0=*reinterpret_cast<const bf16x8*>(kb+d0*2048);
    const bf16x8 b1=*reinterpret_cast<const bf16x8*>(kb+d0*2048+512);
    if(d0==0){p0=__builtin_amdgcn_mfma_f32_32x32x16_bf16(b0,qr[0],negm,0,0,0);p1=__builtin_amdgcn_mfma_f32_32x32x16_bf16(b1,qr[0],negm,0,0,0);}
    else{p0=__builtin_amdgcn_mfma_f32_32x32x16_bf16(b0,qr[d0],p0,0,0,0);p1=__builtin_amdgcn_mfma_f32_32x32x16_bf16(b1,qr[d0],p1,0,0,0);}}
}
typedef __attribute__((address_space(3))) const char* lds_cptr;
typedef short v4i16_t __attribute__((ext_vector_type(4)));
__device__ __forceinline__ void kload8(bf16x8*kf,lds_cptr kp){
  kf[0]=*(const __attribute__((address_space(3))) bf16x8*)(kp);      kf[1]=*(const __attribute__((address_space(3))) bf16x8*)(kp+512);
  kf[2]=*(const __attribute__((address_space(3))) bf16x8*)(kp+2048); kf[3]=*(const __attribute__((address_space(3))) bf16x8*)(kp+2560);
  kf[4]=*(const __attribute__((address_space(3))) bf16x8*)(kp+4096); kf[5]=*(const __attribute__((address_space(3))) bf16x8*)(kp+4608);
  kf[6]=*(const __attribute__((address_space(3))) bf16x8*)(kp+6144); kf[7]=*(const __attribute__((address_space(3))) bf16x8*)(kp+6656);
}
__device__ __forceinline__ void kload2(bf16x8*kf,lds_cptr kp,int j){ kf[2*j]=*(const __attribute__((address_space(3))) bf16x8*)(kp+j*2048); kf[2*j+1]=*(const __attribute__((address_space(3))) bf16x8*)(kp+j*2048+512); }
__device__ __forceinline__ s16x4 vtr(lds_cptr p){ return __builtin_bit_cast(s16x4,__builtin_amdgcn_ds_read_tr16_b64_v4i16((__attribute__((address_space(3))) v4i16_t*)p)); }
__device__ __forceinline__ float rowmax(const f32x16&p0,const f32x16&p1){
  float a=max3f(p0[0],p0[1],p1[0]),b=max3f(p0[2],p0[3],p1[1]);a=max3f(a,p1[2],p1[3]);
  #pragma unroll
  for(int r=4;r<16;r+=4){a=max3f(a,p0[r],p0[r+1]);b=max3f(b,p0[r+2],p0[r+3]);a=max3f(a,p1[r],p1[r+1]);b=max3f(b,p1[r+2],p1[r+3]);}
  const float m=max2f(a,b);
  auto rr=__builtin_amdgcn_permlane32_swap(__float_as_uint(m),__float_as_uint(m),false,false);
  return max2f(__uint_as_float(rr[0]),__uint_as_float(rr[1]));
}
__device__ __forceinline__ void pv(f32x16*o,int vb,bf16x8 pa0,bf16x8 pa1,bf16x8 pa2,bf16x8 pa3){
  #pragma unroll
  for(int d0=0;d0<2;++d0){s16x4 lo[4],hi[4];
    #pragma unroll
    for(int ks=0;ks<4;++ks){
      asm volatile("ds_read_b64_tr_b16 %0,%1 offset:%c2":"=&v"(lo[ks]):"v"(vb),"i"(d0*4096+ks*1024):"memory");
      asm volatile("ds_read_b64_tr_b16 %0,%1 offset:%c2":"=&v"(hi[ks]):"v"(vb),"i"(d0*4096+ks*1024+512):"memory");}
    asm volatile("s_waitcnt lgkmcnt(0)":::"memory");SBAR();
    #define PK(k) (bf16x8){lo[k][0],lo[k][1],lo[k][2],lo[k][3],hi[k][0],hi[k][1],hi[k][2],hi[k][3]}
    o[d0]=__builtin_amdgcn_mfma_f32_32x32x16_bf16(pa0,PK(0),o[d0],0,0,0);
    o[d0]=__builtin_amdgcn_mfma_f32_32x32x16_bf16(pa1,PK(1),o[d0],0,0,0);
    o[d0]=__builtin_amdgcn_mfma_f32_32x32x16_bf16(pa2,PK(2),o[d0],0,0,0);
    o[d0]=__builtin_amdgcn_mfma_f32_32x32x16_bf16(pa3,PK(3),o[d0],0,0,0);
    #undef PK
  }
}

#ifndef ATTN_STORE16
#define ATTN_STORE16(p,v) (*(u32x4*)(p)=(v))
#endif
template<int THRL,bool FIXED> __device__ __forceinline__ void attn_unit(int qb,const bf16*Q,const bf16*__restrict__ Kh,const bf16*__restrict__ Vh,bf16*O,const int*__restrict__ cid,char*shm,const int wid){
  const int lane=lane_asm(),tid=wid*64+lane,r32=lane&31,hi=lane>>5;
  const int q0=qb*QB;
  const bf16*Qw=Q+(long)(q0+wid*QBLK)*DM;
  { __attribute__((address_space(3))) int* cw=(__attribute__((address_space(3))) int*)((__attribute__((address_space(3))) char*)shm+LDS_CID); if(tid<256)cw[tid]=cid[q0+tid]; }
  const lds_iptr cidl=(lds_iptr)((__attribute__((address_space(3))) const char*)shm+LDS_CID);
  const unsigned lds0=(unsigned)(uintptr_t)shm;
  float*wsf=(float*)(shm+LDS_WS)+wid*64;
  const bf16*ksrc=Kh+(long)lane*DM+wid*8;
  const bf16*vsrc=Vh+(long)(16*(wid&3)+(lane>>2))*DM+(wid>>2)*32+(lane&3)*8;
  const unsigned kdst=lds0+LDS_K+wid*1024, vdst=lds0+LDS_V+wid*1024;
  #define DMA_K(t,slot) glds16(ksrc+(long)(t)*KVBLK*DM,(unsigned)__builtin_amdgcn_readfirstlane(kdst+(slot)))
  #define DMA_V(t,slot) do{ glds16(vsrc+(long)(t)*KVBLK*DM,(unsigned)__builtin_amdgcn_readfirstlane(vdst+2*(slot))); glds16(vsrc+64+(long)(t)*KVBLK*DM,(unsigned)__builtin_amdgcn_readfirstlane(vdst+2*(slot)+8192)); }while(0)
  const int vb0=(int)(lds0+LDS_V)+((lane>>4)&1)*32+(lane&3)*8+(4*hi+((lane&15)>>2))*64;
  const char*Kbase=shm+LDS_K; bf16x8 kf[8];
  const lds_cptr shm3=(lds_cptr)shm; const lds_cptr kp0=shm3+LDS_K+hi*1024+r32*16; const lds_cptr vp0=shm3+LDS_V+((lane>>4)&1)*32+(lane&3)*8+(4*hi+((lane&15)>>2))*64;
  const int NT=(q0+QB)/KVBLK;
  DMA_K(0,0);DMA_V(0,0);DMA_K(1,SLOTB);
  bf16x8 qr[4];
  #pragma unroll
  for(int d0=0;d0<4;++d0)qr[d0]=*reinterpret_cast<const bf16x8*>(&Qw[(long)r32*DM+d0*16+hi*8]);
  float mhat=0.f,l_reg=0.f;f32x16 o[4];o[0]=f32x16{};o[1]=f32x16{};o[2]=f32x16{};o[3]=f32x16{};
  const int qrel=wid*QBLK+r32;
  #define CMASK(P0,P1,t) do{int jb_=(t)-(NT-4); if(jb_>=0)cmask(P0,P1,cidl+64*jb_,qc,hi);}while(0)
  bool resc=false;
  #define START(P0,P1) do{ resc=false; \
    if constexpr(!FIXED){ const float rm=rowmax(P0,P1); const float dl=rm; mhat=fadd_s(mhat,dl); \
      _Pragma("unroll") for(int r=0;r<16;++r){P0[r]=fsub_s(P0[r],dl);P1[r]=fsub_s(P1[r],dl);} \
      } \
    _Pragma("unroll") for(int r=0;r<16;++r)P0[r]=__builtin_amdgcn_exp2f(P0[r]); }while(0)
  #define RESC() do{ if constexpr(!FIXED) if(resc){ asm volatile("s_waitcnt lgkmcnt(0)":::"memory"); \
      _Pragma("unroll") for(int d_=0;d_<4;++d_) _Pragma("unroll") for(int r=0;r<16;++r)o[d_][r]*=wsf[crow(r,hi)]; } }while(0)
  f32x16 pA0,pA1,pB0,pB1;
  int sl_prev=0,sl_cur=0,sl_next=SLOTB;
  #define ROT() do{sl_prev=sl_cur;sl_cur=sl_next;sl_next=(sl_next==(NSLOT-1)*SLOTB)?0:sl_next+SLOTB;}while(0)
  DMA_K(2,2*SLOTB);
  WAIT_BAR(4);
  const int qc=cidl[qrel];
  qkt(pA0,pA1,Kbase,qr,r32,hi);asm volatile("s_nop 15\n\ts_nop 7":"+v"(pA0),"+v"(pA1));CMASK(pA0,pA1,0);
  START(pA0,pA1);
  _Pragma("unroll") for(int r=0;r<16;++r)pA1[r]=__builtin_amdgcn_exp2f(pA1[r]);
  WAIT_BAR(0);
  DMA_K(3,0);DMA_V(1,SLOTB);
  ROT();
  kload8(kf,kp0+sl_cur);
  WAIT_BAR(3);
  s16x4 vlo[8],vhi[8]; u32x4 pw0,pw1,pw2,pw3;
  #define PKW(P,B) cvtpk_s(P[B],P[B+1])
  #define PAF(k) __builtin_bit_cast(bf16x8,pw##k)
  #define VFR(i) (bf16x8){vlo[i][0],vlo[i][1],vlo[i][2],vlo[i][3],vhi[i][0],vhi[i][1],vhi[i][2],vhi[i][3]}
  #define PIN(x) asm volatile("":"+v"(x))
  #define MX3(a,b,c) __builtin_fmaxf(__builtin_fmaxf((a),(b)),(c))
  #define GAPA(MF,A0,A1,A2,A3,W0,W1,PW) do{ MF; sacc+=A0; sacc+=A1; sacc+=A2; sacc+=A3; PIN(sacc); W0; W1; PIN(PW); SBAR(); }while(0)
  #define EX(v) __builtin_amdgcn_exp2f(v)
  #define GAPB(MF,X,B) do{ MF; X[B]=EX(X[B]); X[B+1]=EX(X[B+1]); X[B+2]=EX(X[B+2]); X[B+3]=EX(X[B+3]); PIN(X); SBAR(); }while(0)
  #define VRD(i) do{ vlo[i]=vtr(vp_+(((i)>>2)*4096+((i)&3)*1024)); vhi[i]=vtr(vp_+(((i)>>2)*4096+((i)&3)*1024+512)); }while(0)
  #define VRD2(i) do{ vlo[i]=vtr(vp_+(8192+((i)>>2)*4096+((i)&3)*1024)); vhi[i]=vtr(vp_+(8192+((i)>>2)*4096+((i)&3)*1024+512)); SBAR(); }while(0)
  #define GAPB2(MF,X,B) do{ MF; if constexpr(FIXED){ X[B]=EX(X[B]); X[B+1]=EX(X[B+1]); } else { X[B]=EX(X[B]-mhat); X[B+1]=EX(X[B+1]-mhat); } PIN(X); SBAR(); }while(0)
  #define KRD(G,j) do{ if(G){ kload2(kf,kp0+sl_next,j); SBAR(); } }while(0)
  #define STEP(C0,C1,P0,P1,t,GK,GV,GL) do{ SBAR(); \
    const lds_cptr vp_=vp0+2*sl_prev; \
    VRD(0); SBAR(); float sacc=(P0[0]+P0[1]); \
    GAPA(C0=__builtin_amdgcn_mfma_f32_32x32x16_bf16(kf[0],qr[0],f32x16{},0,0,0), P0[2],P0[3],P0[4],P0[5],     pw0[0]=PKW(P0,0), pw0[1]=PKW(P0,2), pw0); \
    VRD(4); SBAR(); GAPA(C1=__builtin_amdgcn_mfma_f32_32x32x16_bf16(kf[1],qr[0],f32x16{},0,0,0), P0[6],P0[7],P0[8],P0[9],     pw0[2]=PKW(P0,4), pw0[3]=PKW(P0,6), pw0); \
    VRD(1); SBAR(); GAPA(C0=__builtin_amdgcn_mfma_f32_32x32x16_bf16(kf[2],qr[1],C0,0,0,0),   P0[10],P0[11],P0[12],P0[13], pw1[0]=PKW(P0,8), pw1[1]=PKW(P0,10), pw1); \
    VRD(5); SBAR(); GAPA(C1=__builtin_amdgcn_mfma_f32_32x32x16_bf16(kf[3],qr[1],C1,0,0,0),   P0[14],P0[15],P1[0],P1[1],   pw1[2]=PKW(P0,12),pw1[3]=PKW(P0,14), pw1); \
    VRD(2); SBAR(); GAPA(C0=__builtin_amdgcn_mfma_f32_32x32x16_bf16(kf[4],qr[2],C0,0,0,0),   P1[2],P1[3],P1[4],P1[5],     pw2[0]=PKW(P1,0), pw2[1]=PKW(P1,2), pw2); \
    VRD(6); SBAR(); GAPA(C1=__builtin_amdgcn_mfma_f32_32x32x16_bf16(kf[5],qr[2],C1,0,0,0),   P1[6],P1[7],P1[8],P1[9],     pw2[2]=PKW(P1,4), pw2[3]=PKW(P1,6), pw2); \
    VRD(3); SBAR(); GAPA(C0=__builtin_amdgcn_mfma_f32_32x32x16_bf16(kf[6],qr[3],C0,0,0,0),   P1[10],P1[11],P1[12],P1[13], pw3[0]=PKW(P1,8), pw3[1]=PKW(P1,10), pw3); \
    VRD(7); SBAR(); GAPA(C1=__builtin_amdgcn_mfma_f32_32x32x16_bf16(kf[7],qr[3],C1,0,0,0),   P1[14],P1[15],0.f,0.f,       pw3[2]=PKW(P1,12),pw3[3]=PKW(P1,14), pw3); \
    l_reg+=sacc; \
    if(GK){DMA_K((t)+3,sl_cur);} if(GV){DMA_V((t)+1,sl_next);} \
    CMASK(C0,C1,t); \
    if constexpr(!FIXED){ float a=MX3(C0[0],C0[1],C1[0]),b=MX3(C0[2],C0[3],C1[1]); a=MX3(a,C1[2],C1[3]); \
      _Pragma("unroll") for(int r=4;r<16;r+=4){a=MX3(a,C0[r],C0[r+1]);b=MX3(b,C0[r+2],C0[r+3]);a=MX3(a,C1[r],C1[r+1]);b=MX3(b,C1[r+2],C1[r+3]);} \
      float rm=__builtin_fmaxf(a,b); { auto rr=__builtin_amdgcn_permlane32_swap(__float_as_uint(rm),__float_as_uint(rm),false,false); rm=__builtin_fmaxf(__uint_as_float(rr[0]),__uint_as_float(rr[1])); } \
      rm-=mhat; resc=false; \
      if(__builtin_expect(__any(rm>(float)THRL),0)){ const float dl=__builtin_fmaxf(rm,0.f); mhat+=dl; \
        const float f=__builtin_amdgcn_exp2f(-dl); l_reg*=f; if(hi==0)wsf[r32]=f; resc=true; } \
      } \
    SBAR(); \
    GAPB2(o[0]=__builtin_amdgcn_mfma_f32_32x32x16_bf16(PAF(0),VFR(0),o[0],0,0,0), C0,0); VRD2(0); \
    GAPB2(o[1]=__builtin_amdgcn_mfma_f32_32x32x16_bf16(PAF(0),VFR(4),o[1],0,0,0), C0,2); VRD2(4); \
    KRD(GL,0); GAPB2(o[0]=__builtin_amdgcn_mfma_f32_32x32x16_bf16(PAF(1),VFR(1),o[0],0,0,0), C0,4); VRD2(1); \
    KRD(GL,1); GAPB2(o[1]=__builtin_amdgcn_mfma_f32_32x32x16_bf16(PAF(1),VFR(5),o[1],0,0,0), C0,6); VRD2(5); \
    KRD(GL,2); GAPB2(o[0]=__builtin_amdgcn_mfma_f32_32x32x16_bf16(PAF(2),VFR(2),o[0],0,0,0), C0,8); VRD2(2); \
    KRD(GL,3); GAPB2(o[1]=__builtin_amdgcn_mfma_f32_32x32x16_bf16(PAF(2),VFR(6),o[1],0,0,0), C0,10); VRD2(6); \
    GAPB2(o[0]=__builtin_amdgcn_mfma_f32_32x32x16_bf16(PAF(3),VFR(3),o[0],0,0,0), C0,12); VRD2(3); \
    GAPB2(o[1]=__builtin_amdgcn_mfma_f32_32x32x16_bf16(PAF(3),VFR(7),o[1],0,0,0), C0,14); VRD2(7); \
    GAPB2(o[2]=__builtin_amdgcn_mfma_f32_32x32x16_bf16(PAF(0),VFR(0),o[2],0,0,0), C1,0); \
    GAPB2(o[3]=__builtin_amdgcn_mfma_f32_32x32x16_bf16(PAF(0),VFR(4),o[3],0,0,0), C1,2); \
    GAPB2(o[2]=__builtin_amdgcn_mfma_f32_32x32x16_bf16(PAF(1),VFR(1),o[2],0,0,0), C1,4); \
    GAPB2(o[3]=__builtin_amdgcn_mfma_f32_32x32x16_bf16(PAF(1),VFR(5),o[3],0,0,0), C1,6); \
    GAPB2(o[2]=__builtin_amdgcn_mfma_f32_32x32x16_bf16(PAF(2),VFR(2),o[2],0,0,0), C1,8); \
    GAPB2(o[3]=__builtin_amdgcn_mfma_f32_32x32x16_bf16(PAF(2),VFR(6),o[3],0,0,0), C1,10); \
    GAPB2(o[2]=__builtin_amdgcn_mfma_f32_32x32x16_bf16(PAF(3),VFR(3),o[2],0,0,0), C1,12); \
    GAPB2(o[3]=__builtin_amdgcn_mfma_f32_32x32x16_bf16(PAF(3),VFR(7),o[3],0,0,0), C1,14); \
    }while(0)
  int t=1;
  #undef CMASK
  #define CMASK(P0,P1,t) do{}while(0)
  for(;t+5<NT;t+=2){
    STEP(pB0,pB1,pA0,pA1,t,true,true,true);     WAIT_BAR(3); RESC(); ROT();
    STEP(pA0,pA1,pB0,pB1,t+1,true,true,true);   WAIT_BAR(3); RESC(); ROT();
  }
  #undef CMASK
  #define CMASK(P0,P1,t) do{int jb_=(t)-(NT-4); if(jb_>=0)cmask(P0,P1,cidl+64*jb_,qc,hi);}while(0)
  #define ENDW(tt) do{ if((tt)+3<NT){WAIT_BAR(3);} else if((tt)+2<NT){WAIT_BAR(2);} else {WAIT_BAR(0);} }while(0)
  for(;t+1<NT;t+=2){
    STEP(pB0,pB1,pA0,pA1,t,(t+3<NT),(t+1<NT),(t+1<NT));       ENDW(t);   RESC(); ROT();
    STEP(pA0,pA1,pB0,pB1,t+1,(t+4<NT),(t+2<NT),(t+2<NT));     ENDW(t+1); RESC(); ROT();
  }
  STEP(pB0,pB1,pA0,pA1,NT-1,false,false,false); RESC();
  { float sacc=pB0[0]+pB0[1]; _Pragma("unroll") for(int r=2;r<16;++r)sacc+=pB0[r]; _Pragma("unroll") for(int r=0;r<16;++r)sacc+=pB1[r]; l_reg+=sacc;
    pw0=(u32x4){PKW(pB0,0),PKW(pB0,2),PKW(pB0,4),PKW(pB0,6)};pw1=(u32x4){PKW(pB0,8),PKW(pB0,10),PKW(pB0,12),PKW(pB0,14)};pw2=(u32x4){PKW(pB1,0),PKW(pB1,2),PKW(pB1,4),PKW(pB1,6)};pw3=(u32x4){PKW(pB1,8),PKW(pB1,10),PKW(pB1,12),PKW(pB1,14)};
    SBAR(); pv(o,vb0+2*sl_cur,PAF(0),PAF(1),PAF(2),PAF(3)); pv(o+2,vb0+2*sl_cur+8192,PAF(0),PAF(1),PAF(2),PAF(3)); }
  #undef PKW
  #undef PAF
  #undef VFR
  #undef PIN
  #undef MX3
  #undef GAPA
  #undef GAPB
  #undef EX
  #undef VRD
  #undef VRD2
  #undef GAPB2
  #undef KRD
  #undef STEP
  #undef ENDW
  {auto rr=__builtin_amdgcn_permlane32_swap(__float_as_uint(l_reg),__float_as_uint(l_reg),false,false);l_reg=__uint_as_float(rr[0])+__uint_as_float(rr[1]);}
  if(hi==0)wsf[32+r32]=l_reg;asm volatile("s_waitcnt lgkmcnt(0)":::"memory");
  float rli[16];
  #pragma unroll
  for(int r=0;r<16;++r)rli[r]=__builtin_amdgcn_rcpf(wsf[32+crow(r,hi)]);
  bf16*Ow=O+(long)(q0+wid*QBLK)*DM;
  { bf16*stg=(bf16*)(shm+LDS_OST)+wid*2048;
    #pragma unroll
    for(int e=0;e<2;++e){
      #pragma unroll
      for(int r=0;r<16;++r){const int orow=crow(r,hi);
        #pragma unroll
        for(int d0=0;d0<2;++d0)stg[orow*64+d0*32+r32]=__float2bfloat16(o[2*e+d0][r]*rli[r]);}
      asm volatile("s_waitcnt lgkmcnt(0)":::"memory");
      #pragma unroll
      for(int i=0;i<4;++i){const int row=i*8+(lane>>3),ch=lane&7; const u32x4 v=*(const u32x4*)(stg+row*64+ch*8); ATTN_STORE16(Ow+(long)row*DM+e*64+ch*8,v);}
      asm volatile("s_waitcnt lgkmcnt(0)":::"memory"); } }
  asm volatile("s_waitcnt lgkmcnt(0)\n\ts_barrier":::"memory");
  #undef DMA_K
  #undef DMA_V
  #undef CMASK
  #undef START
  #undef RESC
  #undef ROT
}
constexpr int ATTN_LDS_BYTES=LDS_BYTES;
struct AttnTensors { const bf16* Q; const bf16* K; const bf16* V; bf16* O; const int* cid; const float* qn; const float* kn; };
struct AttnUnit { int bh; int qb; };
struct StaticOrder {
  int vcu,G;
  __device__ __forceinline__ explicit StaticOrder(int grid,int block):vcu((grid%8==0)?(block%8)*(grid/8)+block/8:block),G(grid){}
  __device__ __forceinline__ bool next(int i,AttnUnit&u)const{ const int v=vcu+(i>>2)*G; if(v>=256)return false; const int s=v&15,k=i&3; u.bh=v>>4; u.qb=(k&1)?(32*(k>>1)+31-s):(32*(k>>1)+s); return true; }
};
template<class Sched,int THRL=8> __device__ __forceinline__ void attn_phase(char*lds,const AttnTensors&T,const Sched&S,const int wid){
  bool fixed; { const int l=lane_asm(); float gq=__builtin_fabsf(T.qn[l]),gk=__builtin_fabsf(T.kn[l]);
    #pragma unroll
    for(int o_=1;o_<64;o_<<=1){gq=__builtin_fmaxf(gq,__shfl_xor(gq,o_));gk=__builtin_fmaxf(gk,__shfl_xor(gk,o_));}
    const float bound=C2*64.0f*1.03f*gq*gk; fixed=__builtin_amdgcn_readfirstlane((int)(bound<=60.0f))!=0; }
  AttnUnit u;
  for(int i=0;S.next(i,u);++i){ const int h=u.bh>>1,c=u.bh&1;
    if(fixed) attn_unit<THRL,true>(u.qb,T.Q+u.bh*64,T.K+u.bh*64,T.V+h*128,T.O+(long)c*SEQ*DM+h*128,T.cid,lds,wid);
    else attn_unit<THRL,false>(u.qb,T.Q+u.bh*64,T.K+u.bh*64,T.V+h*128,T.O+(long)c*SEQ*DM+h*128,T.cid,lds,wid); }
}
#undef SBAR
#undef WAIT_BAR
}
#define GAS __attribute__((address_space(1)))
#define LAS __attribute__((address_space(3)))
typedef unsigned short bf16;
typedef unsigned v4u __attribute__((ext_vector_type(4)));
typedef unsigned v2u __attribute__((ext_vector_type(2)));
typedef float f32x4 __attribute__((ext_vector_type(4)));
#define LDS_WAIT() asm volatile("s_waitcnt lgkmcnt(0)" ::: "memory")

constexpr int NWAVES = 8, NTHR = 512;
constexpr int M = 16384, DMODEL = 2048, FF = 5632, NUP = 2 * FF, NIN = 4096, NMOD = 9 * DMODEL;
constexpr int NPH = 16;
#ifndef MK_N_LAUNCHES
#define MK_N_LAUNCHES 1
#endif
constexpr size_t MiB = 1u << 20;
constexpr size_t WS_MODP = 1 * MiB, WS_MOD = 4 * MiB, WS_CID = 4 * MiB + 512 * 1024, WS_A16 = 5 * MiB, WS_CS = 6 * MiB, WS_SSQ = 7 * MiB, WS_BV = 8 * MiB, WS_GM = 9 * MiB;
constexpr size_t WS_W1U = 16 * MiB, WS_W1D = 60 * MiB, WS_W2U = 82 * MiB, WS_W2D = 126 * MiB, WS_WIN = 148 * MiB, WS_WOUT = 164 * MiB, WS_WGLU = 172 * MiB, WS_BE = 174 * MiB, WS_BY = 186 * MiB;
constexpr size_t WS_HB = 198 * MiB, WS_H = 262 * MiB, WS_Q = 262 * MiB, WS_K = 294 * MiB, WS_V = 326 * MiB, WS_UGS = 358 * MiB, WS_E = 406 * MiB, WS_END = 438 * MiB;
constexpr size_t WS_O32 = WS_HB, WS_YG = WS_E, WS_Y2 = WS_Q, WS_MIX = WS_K;
static_assert(WS_H + (size_t)M * FF * 2 <= WS_END && WS_UGS + (size_t)1024 * 64 * 384 * 2 <= WS_E && WS_E + (size_t)1024 * 8192 * 4 <= WS_END, "ws map");
constexpr int LDS_BYTES = 147456;

__device__ __forceinline__ unsigned f2bf(float f) { unsigned u = __builtin_bit_cast(unsigned, f); return (u + 0x7fffu + ((u >> 16) & 1u)) >> 16; }
__device__ __forceinline__ unsigned pk2(float lo, float hi) { return f2bf(lo) | (f2bf(hi) << 16); }
__device__ __forceinline__ float blo(unsigned w) { return __uint_as_float(w << 16); }
__device__ __forceinline__ float bhi(unsigned w) { return __uint_as_float(w & 0xffff0000u); }
__device__ __forceinline__ float wave_sum(float v) {
#pragma unroll
    for (int o = 1; o < 64; o <<= 1) v += __shfl_xor(v, o);
    return v;
}
__device__ __forceinline__ void unpack16(const bf16* p, float (&v)[16]) {
    const v4u a = *(const v4u*)p, b = *(const v4u*)(p + 8);
    v[0] = blo(a.x); v[1] = bhi(a.x); v[2] = blo(a.y); v[3] = bhi(a.y); v[4] = blo(a.z); v[5] = bhi(a.z); v[6] = blo(a.w); v[7] = bhi(a.w);
    v[8] = blo(b.x); v[9] = bhi(b.x); v[10] = blo(b.y); v[11] = bhi(b.y); v[12] = blo(b.z); v[13] = bhi(b.z); v[14] = blo(b.w); v[15] = bhi(b.w);
}
__device__ __forceinline__ void pack16(bf16* p, const float (&v)[16]) {
    v4u a, b; a.x = pk2(v[0], v[1]); a.y = pk2(v[2], v[3]); a.z = pk2(v[4], v[5]); a.w = pk2(v[6], v[7]);
    b.x = pk2(v[8], v[9]); b.y = pk2(v[10], v[11]); b.z = pk2(v[12], v[13]); b.w = pk2(v[14], v[15]);
    *(v4u*)p = a; *(v4u*)(p + 8) = b;
}

__device__ __forceinline__ void p0_transpose_item(const float* W, int K, int N, bf16* WT, int mode, LAS float* scr, int item, int lane) {
    const int nblk = N / 32, kb = item / nblk, nb = item % nblk, k0 = 64 * kb, n0 = 32 * nb;
#pragma unroll 8
    for (int i = 0; i < 32; ++i) { const int kk = 2 * i + (lane >> 5); scr[kk * 33 + (lane & 31)] = W[(size_t)(k0 + kk) * N + n0 + (lane & 31)]; }
    LDS_WAIT(); asm volatile("" ::: "memory");
    const int c = lane & 7;
#pragma unroll
    for (int j = 0; j < 4; ++j) { const int n = (lane >> 3) + 8 * j; const LAS float* s = scr + (8 * c) * 33 + n;
        v4u o; o.x = pk2(s[0 * 33], s[1 * 33]); o.y = pk2(s[2 * 33], s[3 * 33]); o.z = pk2(s[4 * 33], s[5 * 33]); o.w = pk2(s[6 * 33], s[7 * 33]);
        const int nn = n0 + n; const int drow = mode == 0 ? nn : ((nn >> 7) * 256 + (mode == 2 ? 128 : 0) + (nn & 127));
        *(v4u*)(WT + (size_t)drow * K + k0 + 8 * c) = o; }
    LDS_WAIT(); asm volatile("" ::: "memory");
}
struct TrItem { const float* W; bf16* WT; int K, N, mode, item; };
__device__ __forceinline__ void tr_load(const TrItem& t, int lane, f32x4 (&r)[8]) {
    const int nblk = t.N / 32, kb = t.item / nblk, nb = t.item % nblk;
    const float* p = t.W + (size_t)(64 * kb + (lane >> 3)) * t.N + 32 * nb + (lane & 7) * 4;
#pragma unroll
    for (int i = 0; i < 8; ++i) r[i] = __builtin_nontemporal_load((const f32x4*)(p + (size_t)(8 * i) * t.N));
}
__device__ __forceinline__ void tr_store(const TrItem& t, int lane, const f32x4 (&r)[8], LAS float* scr) {
    const int nblk = t.N / 32, kb = t.item / nblk, nb = t.item % nblk, k0 = 64 * kb, n0 = 32 * nb;
#pragma unroll
    for (int i = 0; i < 8; ++i) { LAS float* d = scr + (8 * i + (lane >> 3)) * 33 + (lane & 7) * 4; d[0] = r[i].x; d[1] = r[i].y; d[2] = r[i].z; d[3] = r[i].w; }
    LDS_WAIT(); asm volatile("" ::: "memory");
    const int c = lane & 7;
#pragma unroll
    for (int j = 0; j < 4; ++j) { const int n = (lane >> 3) + 8 * j; const LAS float* s = scr + (8 * c) * 33 + n;
        v4u o; o.x = pk2(s[0 * 33], s[1 * 33]); o.y = pk2(s[2 * 33], s[3 * 33]); o.z = pk2(s[4 * 33], s[5 * 33]); o.w = pk2(s[6 * 33], s[7 * 33]);
        const int nn = n0 + n; int drow = t.mode == 0 ? nn : ((nn >> 7) * 256 + (t.mode == 2 ? 128 : 0) + (nn & 127));
        if (t.mode == 3) drow = nn < 2048 ? ((nn >> 8) * 256 + ((nn >> 5) & 1) * 128 + ((nn >> 6) & 3) * 32 + (nn & 31)) : nn;
        *(v4u*)(t.WT + (size_t)drow * t.K + k0 + 8 * c) = o; }
    LDS_WAIT(); asm volatile("" ::: "memory");
}
__device__ __forceinline__ void norm_load2(const float* X, int r0, int r1, int lane, f32x4 (&v)[2][8]) {
    const f32x4* x0 = (const f32x4*)(X + (size_t)(r0 < M ? r0 : 0) * DMODEL) + lane; const f32x4* x1 = (const f32x4*)(X + (size_t)(r1 < M ? r1 : 0) * DMODEL) + lane;
#pragma unroll
    for (int j = 0; j < 8; ++j) { v[0][j] = x0[64 * j]; v[1][j] = x1[64 * j]; }
}
__device__ __forceinline__ void norm_store2(bf16* O, int r0, int r1, int lane, const f32x4 (&v)[2][8], const f32x4 (&gm)[8], const f32x4 (&hs)[8]) {
#pragma unroll
    for (int q = 0; q < 2; ++q) { const int r = q == 0 ? r0 : r1; float s = 0.f;
#pragma unroll
        for (int j = 0; j < 8; ++j) s += (v[q][j].x * v[q][j].x + v[q][j].y * v[q][j].y) + (v[q][j].z * v[q][j].z + v[q][j].w * v[q][j].w);
        const float rstd = 1.0f / sqrtf(wave_sum(s) * (1.0f / DMODEL) + 1e-6f);
        if (r < M) { bf16* orow = O + (size_t)r * DMODEL;
#pragma unroll
            for (int j = 0; j < 8; ++j) { const f32x4 y = (v[q][j] * rstd) * gm[j] + hs[j]; v2u o; o.x = pk2(y.x, y.y); o.y = pk2(y.z, y.w); *(v2u*)(orow + 4 * (lane + 64 * j)) = o; } } }
}
__device__ __forceinline__ void norm_mod_pass(const float* X, const float* gam, const float* sc, const float* sh, bf16* O, int gw, int NGW, int lane) {
    f32x4 va[2][8], vb[2][8];
    norm_load2(X, gw, gw + NGW, lane, va);
    f32x4 gm[8], hs[8];
#pragma unroll
    for (int j = 0; j < 8; ++j) { const int col = 4 * (lane + 64 * j); gm[j] = *(const f32x4*)(gam + col) * (*(const f32x4*)(sc + col) + 1.0f); hs[j] = *(const f32x4*)(sh + col); }
    for (int row = gw; row < M; row += 4 * NGW) {
        norm_load2(X, row + 2 * NGW, row + 3 * NGW, lane, vb);
        norm_store2(O, row, row + NGW, lane, va, gm, hs);
        norm_load2(X, row + 4 * NGW, row + 5 * NGW, lane, va);
        norm_store2(O, row + 2 * NGW, row + 3 * NGW, lane, vb, gm, hs);
    }
}
__device__ __forceinline__ void norm_mod_row(const float* xrow, const float* gam, const float* sc, const float* sh, bf16* orow, int lane) {
    const f32x4* xr = (const f32x4*)xrow + lane;
    f32x4 v[8]; float s = 0.f;
#pragma unroll
    for (int j = 0; j < 8; ++j) { v[j] = xr[64 * j]; s += (v[j].x * v[j].x + v[j].y * v[j].y) + (v[j].z * v[j].z + v[j].w * v[j].w); }
    const float rstd = 1.0f / sqrtf(wave_sum(s) * (1.0f / DMODEL) + 1e-6f);
#pragma unroll
    for (int j = 0; j < 8; ++j) { const int col = 4 * (lane + 64 * j);
        const f32x4 g4 = *(const f32x4*)(gam + col), c4 = *(const f32x4*)(sc + col), h4 = *(const f32x4*)(sh + col);
        const f32x4 y = (v[j] * rstd * g4) * (c4 + 1.0f) + h4;
        v2u o; o.x = pk2(y.x, y.y); o.y = pk2(y.z, y.w); *(v2u*)(orow + col) = o; }
}
__device__ __forceinline__ void ssm_gen(int g, LAS float* S, const float* a_re, const float* a_im, const float* log_dt, const float* b_re, const float* b_im,
                                        const float* c_re, const float* c_im, bf16* BY, bf16* BE, float* A16, int tid) {
    LAS float* ljr = S; LAS float* lji = S + 17 * 64;
    LAS float* bbr = S + 2 * 17 * 64; LAS float* bbi = bbr + 1024;
    LAS float* ccr = bbi + 1024; LAS float* cci = ccr + 1024;
    LAS float* km = cci + 1024;
    const float dt = expf(log_dt[g]);
    for (int idx = tid; idx < 17 * 64; idx += NTHR) { const int j = idx >> 6, p = idx & 63;
        const float re = fminf(a_re[g * 64 + p], -1e-4f), im = a_im[g * 64 + p];
        const float mag = expf((float)j * re * dt), ang = (float)j * im * dt;
        ljr[idx] = mag * cosf(ang); lji[idx] = mag * sinf(ang); }
    for (int idx = tid; idx < 1024; idx += NTHR) { const int p = idx >> 4;
        const float re = fminf(a_re[g * 64 + p], -1e-4f), im = a_im[g * 64 + p];
        const float mag = expf(re * dt), ang = im * dt; const float xr = mag * cosf(ang) - 1.0f, xi = mag * sinf(ang);
        const float den = 1.0f / (re * re + im * im); const float qr = (xr * re + xi * im) * den, qi = (xi * re - xr * im) * den;
        const float br = b_re[(size_t)g * 1024 + idx], bi = b_im[(size_t)g * 1024 + idx];
        bbr[idx] = qr * br - qi * bi; bbi[idx] = qr * bi + qi * br;
        ccr[idx] = c_re[(size_t)g * 1024 + idx]; cci[idx] = c_im[(size_t)g * 1024 + idx]; }
    __syncthreads();
    if (tid < 64) { A16[(g * 64 + tid) * 2] = ljr[16 * 64 + tid]; A16[(g * 64 + tid) * 2 + 1] = lji[16 * 64 + tid]; }
    for (int idx = tid; idx < 4096; idx += NTHR) { const int j = idx >> 8, co = (idx >> 4) & 15, ci = idx & 15; float s = 0.f;
        for (int p = 0; p < 64; ++p) { const float cr = ccr[co * 64 + p], cim = cci[co * 64 + p], lr = ljr[j * 64 + p], li = lji[j * 64 + p];
            const float tr = cr * lr - cim * li, ti = cr * li + cim * lr; s += tr * bbr[p * 16 + ci] - ti * bbi[p * 16 + ci]; }
        km[idx] = s; }
    __syncthreads();
    unsigned* BYg = (unsigned*)(BY + (size_t)g * 256 * 384);
    for (int i2 = tid; i2 < 256 * 192; i2 += NTHR) { const int row = i2 / 192, col = (i2 % 192) * 2, tl = row >> 4, co = row & 15; float v[2];
#pragma unroll
        for (int e = 0; e < 2; ++e) { const int cc = col + e;
            if (cc < 256) { const int sl = cc >> 4, ci = cc & 15; v[e] = (tl >= sl) ? km[(tl - sl) * 256 + co * 16 + ci] : 0.f; }
            else { const int q = cc - 256, p = q & 63; const float cr = ccr[co * 64 + p], cim = cci[co * 64 + p], lr = ljr[(tl + 1) * 64 + p], li = lji[(tl + 1) * 64 + p];
                v[e] = (q < 64) ? (cr * lr - cim * li) : -(cr * li + cim * lr); } }
        BYg[i2] = pk2(v[0], v[1]); }
    const int gi = g & 1; unsigned* BEg = (unsigned*)(BE + ((size_t)(g >> 1) * 256 + gi * 128) * 768);
    for (int i2 = tid; i2 < 128 * 384; i2 += NTHR) { const int r = i2 / 384, col = (i2 % 384) * 2, part = r >> 6, p = r & 63; float v[2];
#pragma unroll
        for (int e = 0; e < 2; ++e) { const int c2 = col + e, gj = c2 >= 384 ? 1 : 0, cc = c2 - gj * 384;
            if (gj == gi && cc < 256) { const int sl = cc >> 4, ci = cc & 15; const float lr = ljr[(15 - sl) * 64 + p], li = lji[(15 - sl) * 64 + p], br = bbr[p * 16 + ci], bi = bbi[p * 16 + ci];
                v[e] = part == 0 ? (lr * br - li * bi) : (lr * bi + li * br); }
            else v[e] = 0.f; }
        BEg[i2] = pk2(v[0], v[1]); }
    __syncthreads();
}


#define XB_TMO      128
#define XB_XCNT(j)  (256  + 64 * (j))
#define XB_XSUB(j)  (1280 + 64 * (j))
#define XB_XGEN(j)  (2304 + 64 * (j))
#define XB_TOP      3328
#define XB_TOPGEN   3392
#define XCD_BAR_WORDS 3456
#define XB_SPIN_CAP (1u << 22)
__device__ __forceinline__ unsigned xb_ld(unsigned* p)              { return __hip_atomic_load(p, __ATOMIC_RELAXED, __HIP_MEMORY_SCOPE_AGENT); }
__device__ __forceinline__ unsigned xb_add(unsigned* p, unsigned v) { return __hip_atomic_fetch_add(p, v, __ATOMIC_RELAXED, __HIP_MEMORY_SCOPE_AGENT); }
__device__ __forceinline__ unsigned xb_xcc_id() { return (unsigned)__builtin_amdgcn_s_getreg((3 << 11) | 20) & 0xFu; }
#define XB_SPIN(cond, bar) do { unsigned _sp = 0; while (cond) { __builtin_amdgcn_s_sleep(1); \
    if ((++_sp & 255u) == 0u) { if (xb_ld(&(bar)[XB_TMO])) break; if (_sp > XB_SPIN_CAP) { atomicAdd(&(bar)[XB_TMO], 1u); break; } } } } while (0)
__device__ __forceinline__ void xcd_barrier_complete(unsigned* bar, unsigned x, unsigned& nloc, unsigned& nx) {
    const unsigned G = gridDim.x * gridDim.y * gridDim.z;
    unsigned sum, cnt, mine, sp = 0u;
    for (;;) {
        sum = 0u; cnt = 0u; mine = 0u;
#pragma unroll
        for (unsigned j = 0; j < 16; ++j) { const unsigned c = xb_ld(&bar[XB_XCNT(j)]); sum += c; cnt += (c > 0u) ? 1u : 0u; mine = (j == x) ? c : mine; }
        if (sum == G) break;
        __builtin_amdgcn_s_sleep(1);
        if ((++sp & 255u) == 0u) { if (xb_ld(&bar[XB_TMO])) break; if (sp > XB_SPIN_CAP) { atomicAdd(&bar[XB_TMO], 1u); break; } }
    }
    nloc = mine > 0u ? mine : 1u; nx = cnt > 0u ? cnt : 1u;
}
__device__ __forceinline__ void xcd_barrier(unsigned* bar, volatile LAS unsigned* st, bool lead) {
    asm volatile("s_waitcnt vmcnt(0)" ::: "memory");
    __syncthreads();
    if (lead) {
        __builtin_amdgcn_s_waitcnt(0);
        const unsigned x = xb_xcc_id();
        unsigned nloc = st[0], nx = st[1];
        if (nloc == 0u) { xcd_barrier_complete(bar, x, nloc, nx); st[0] = nloc; st[1] = nx; }
        const unsigned old = xb_add(&bar[XB_XSUB(x)], 1u);
        const unsigned gen = old / nloc;
        if (old + 1u == (gen + 1u) * nloc) {
            __builtin_amdgcn_fence(__ATOMIC_RELEASE, "agent");
            asm volatile("s_waitcnt vmcnt(0)" ::: "memory");
            const unsigned og = xb_add(&bar[XB_TOP], 1u);
            const unsigned tg = og / nx;
            if (og + 1u == (tg + 1u) * nx) xb_add(&bar[XB_TOPGEN], 1u);
            else XB_SPIN(xb_ld(&bar[XB_TOPGEN]) == tg, bar);
            __builtin_amdgcn_fence(__ATOMIC_ACQUIRE, "agent");
            xb_add(&bar[XB_XGEN(x)], 1u);
            asm volatile("s_waitcnt vmcnt(0)" ::: "memory");
        } else {
            XB_SPIN(xb_ld(&bar[XB_XGEN(x)]) == gen, bar);
            __builtin_amdgcn_fence(__ATOMIC_ACQUIRE, "agent");
            asm volatile("s_waitcnt vmcnt(0)" ::: "memory");
        }
    }
    __syncthreads();
}
#define FB_REL 8256
constexpr int TAB_OFF = 131072;
__device__ __forceinline__ const void* ldptr(LAS unsigned char* L, int k) {
    const LAS unsigned* t = (const LAS unsigned*)(L + TAB_OFF) + 2 * k;
    const unsigned lo = __builtin_amdgcn_readfirstlane(t[0]), hi = __builtin_amdgcn_readfirstlane(t[1]);
    return (const void*)(((unsigned long long)hi << 32) | lo);
}
struct Args { const void* in[34]; float* out; unsigned char* ws; int ph_lo, ph_hi; };
static_assert(sizeof(Args) == 34 * 8 + 8 + 8 + 8, "Args has no padding");

__global__ void __launch_bounds__(NTHR, 2) mk_fwd(Args args) {
    extern __shared__ __attribute__((aligned(16))) unsigned char lds[];
    LAS unsigned char* L = (LAS unsigned char*)lds;
    const int wave = __builtin_amdgcn_readfirstlane((int)threadIdx.x >> 6);
    const int G = gridDim.x, bx = blockIdx.x;
    const int gw = bx * NWAVES + wave, NGW = G * NWAVES;
    cg::grid_group grid = cg::this_grid();
    const int lo = args.ph_lo, hi = args.ph_hi;
#ifndef PHMASK
#define PHMASK 0xffff
#endif
#define IN(k) (((PHMASK >> (k)) & 1) && lo <= (k) && (k) < hi)
#define SEAM(k) do { if (IN(k) && IN((k) + 1)) xcd_barrier((unsigned*)p_ws, (volatile LAS unsigned*)(L + TAB_OFF + 512), wave == 0 && lane_asm() == 0); } while (0)
    if (threadIdx.x == 0) { LAS unsigned long long* tb = (LAS unsigned long long*)(L + TAB_OFF);
#pragma unroll
        for (int i = 0; i < 34; ++i) tb[i] = (unsigned long long)args.in[i];
        tb[34] = (unsigned long long)args.out; tb[35] = (unsigned long long)args.ws; ((LAS unsigned*)(L + TAB_OFF + 512))[0] = 0u; ((LAS unsigned*)(L + TAB_OFF + 512))[1] = 0u; }
    __syncthreads();
    if (hi - lo == NPH) {
        if (bx == 0) { for (int i = (int)threadIdx.x; i < XCD_BAR_WORDS; i += NTHR) __hip_atomic_store((unsigned*)args.ws + i, 0u, __ATOMIC_RELAXED, __HIP_MEMORY_SCOPE_AGENT);
            asm volatile("s_waitcnt vmcnt(0)" ::: "memory"); __syncthreads();
            if (threadIdx.x == 0) { __builtin_amdgcn_fence(__ATOMIC_RELEASE, "agent"); asm volatile("s_waitcnt vmcnt(0)" ::: "memory"); __hip_atomic_store((unsigned*)args.ws + FB_REL, 1u, __ATOMIC_RELAXED, __HIP_MEMORY_SCOPE_AGENT); } }
        if (hi < 0) grid.sync();
    }
#define INP(k) ((const float*)ldptr(L, (k)))
#define p_x INP(0)
#define p_cvec INP(1)
#define p_pos ((const int*)ldptr(L, 2))
#define p_w_ada INP(3)
#define p_b_ada INP(4)
#define p_out ((float*)ldptr(L, 34))
#define p_ws ((unsigned char*)ldptr(L, 35))
#define p_modp ((float*)(p_ws + WS_MODP))
#define p_mod ((float*)(p_ws + WS_MOD))
#define p_cid ((int*)(p_ws + WS_CID))
#define p_A16 ((float*)(p_ws + WS_A16))
#define p_CS ((float*)(p_ws + WS_CS))
#define p_SSQ ((unsigned long long*)(p_ws + WS_SSQ))
#define p_BV ((float*)(p_ws + WS_BV))
#define p_GM ((float*)(p_ws + WS_GM))
#define p_W1U ((bf16*)(p_ws + WS_W1U))
#define p_W1D ((bf16*)(p_ws + WS_W1D))
#define p_W2U ((bf16*)(p_ws + WS_W2U))
#define p_W2D ((bf16*)(p_ws + WS_W2D))
#define p_WIN ((bf16*)(p_ws + WS_WIN))
#define p_WOUT ((bf16*)(p_ws + WS_WOUT))
#define p_WGLU ((bf16*)(p_ws + WS_WGLU))
#define p_BE ((bf16*)(p_ws + WS_BE))
#define p_BY ((bf16*)(p_ws + WS_BY))
#define p_HB ((bf16*)(p_ws + WS_HB))
#define p_H ((bf16*)(p_ws + WS_H))
#define p_Q ((bf16*)(p_ws + WS_Q))
#define p_K ((bf16*)(p_ws + WS_K))
#define p_V ((bf16*)(p_ws + WS_V))
#define p_UGS ((bf16*)(p_ws + WS_UGS))
#define p_E ((float*)(p_ws + WS_E))
#define p_O32 ((bf16*)(p_ws + WS_O32))
#define p_YG ((bf16*)(p_ws + WS_YG))
#define p_Y2 ((bf16*)(p_ws + WS_Y2))
#define p_MIX ((bf16*)(p_ws + WS_MIX))
    if (IN(0)) { const int lane = lane_asm(), tid = wave * 64 + lane; (void)tid;
        if (bx < 64) ssm_gen(bx, (LAS float*)L, INP(18), INP(19), INP(20), INP(21), INP(22),
                             INP(23), INP(24), p_BY, p_BE, p_A16, tid);
        for (int t = bx * NTHR + tid; t < M; t += G * NTHR) { const int p = p_pos[t]; p_cid[t] = p >= 0 ? p / 64 : -((63 - p) / 64); }
        for (int i = bx * NTHR + tid; i < M * 8; i += G * NTHR) { const int t = i >> 3, j = i & 7;
            const float inv = (j == 0) ? 1.0f : (j == 1) ? 0.19392274474868576f : (j == 2) ? 0.03760603093086393f : (j == 3) ? 0.007292664737217109f : (j == 4) ? 0.001414213562373095f : (j == 5) ? 0.0002742481756762073f : (j == 6) ? 5.318295896944988e-05f : 1.031338537721246e-05f;
            const float ang = (float)p_pos[t] * inv; p_CS[t * 16 + j] = cosf(ang); p_CS[t * 16 + 8 + j] = sinf(ang); }
        LAS float* scr = (LAS float*)(L + wave * 16384);
        constexpr int I_UP = (DMODEL / 64) * (FF / 32), I_DN = (FF / 64) * (DMODEL / 32), I_IN = (DMODEL / 64) * (NIN / 32), I_GLU = 16 * 32, I_OUT = 32 * 64, I_MOD = 32 * 72;
        constexpr int NTR = 4 * I_UP + 2 * I_DN + I_IN + I_GLU + I_OUT;
        if (bx >= 64 || G <= 64) { const int g0 = (G > 64) ? gw - 64 * NWAVES : gw, gn = (G > 64) ? NGW - 64 * NWAVES : NGW;
            for (int r = g0; r < I_MOD; r += gn) { const int sl = r / 72, cb = r % 72, col = cb * 256 + lane * 4; f32x4 acc = {0.f, 0.f, 0.f, 0.f};
                const float* wp = p_w_ada + (size_t)(sl * 64) * NMOD + col; const float* cp = p_cvec + sl * 64;
#pragma unroll 32
                for (int kk = 0; kk < 64; ++kk) { const float cv = cp[kk]; const float sv = cv / (1.0f + expf(-cv)); acc += __builtin_nontemporal_load((const f32x4*)(wp + (size_t)kk * NMOD)) * sv; }
                *(f32x4*)(p_modp + (size_t)sl * NMOD + col) = acc; } }
#define P0_DECODE(it_, T_) do { int r = (it_); \
            if (r < I_UP) { T_ = TrItem{INP(6), p_W1U, DMODEL, FF, 1, r}; break; } r -= I_UP; \
            if (r < I_UP) { T_ = TrItem{INP(7), p_W1U, DMODEL, FF, 2, r}; break; } r -= I_UP; \
            if (r < I_DN) { T_ = TrItem{INP(8), p_W1D, FF, DMODEL, 0, r}; break; } r -= I_DN; \
            if (r < I_IN) { T_ = TrItem{INP(10), p_WIN, DMODEL, NIN, 3, r}; break; } r -= I_IN; \
            if (r < I_GLU) { T_ = TrItem{INP(26), p_WGLU, 1024, 1024, 0, r}; break; } r -= I_GLU; \
            if (r < I_OUT) { T_ = TrItem{INP(29), p_WOUT, DMODEL, DMODEL, 0, r}; break; } r -= I_OUT; \
            if (r < I_UP) { T_ = TrItem{INP(31), p_W2U, DMODEL, FF, 1, r}; break; } r -= I_UP; \
            if (r < I_UP) { T_ = TrItem{INP(32), p_W2U, DMODEL, FF, 2, r}; break; } r -= I_UP; \
            T_ = TrItem{INP(33), p_W2D, FF, DMODEL, 0, r}; } while (0)
        if (gw < NTR) { TrItem cur, nxt; f32x4 ra[8], rb[8]; int it = gw; P0_DECODE(it, cur); tr_load(cur, lane, ra);
            for (;;) { const int itn = it + NGW; const bool has = itn < NTR;
                if (has) { P0_DECODE(itn, nxt); tr_load(nxt, lane, rb); }
                tr_store(cur, lane, ra, scr);
                if (!has) break;
                it = itn; cur = nxt;
#pragma unroll
                for (int i = 0; i < 8; ++i) ra[i] = rb[i]; } }
#undef P0_DECODE
        __syncthreads();
    }
    if (IN(0) && IN(1)) { if (wave == 0 && lane_asm() == 0) { unsigned* ctl_ = (unsigned*)p_ws; unsigned sp_ = 0;
            while (__hip_atomic_load(ctl_ + FB_REL, __ATOMIC_RELAXED, __HIP_MEMORY_SCOPE_AGENT) != 1u) { __builtin_amdgcn_s_sleep(1); if (++sp_ > (1u << 22)) break; }
            __builtin_amdgcn_fence(__ATOMIC_ACQUIRE, "agent"); asm volatile("s_waitcnt vmcnt(0)" ::: "memory");
            (void)xb_add(ctl_ + XB_XCNT(xb_xcc_id()), 1u); }
        xcd_barrier((unsigned*)p_ws, (volatile LAS unsigned*)(L + TAB_OFF + 512), wave == 0 && lane_asm() == 0); }
    if (IN(1)) { const int lane = lane_asm(), tid = wave * 64 + lane; (void)tid;
        for (int j = bx * NTHR + tid; j < NMOD; j += G * NTHR) { float s = p_b_ada[j];
#pragma unroll
            for (int sl = 0; sl < 32; ++sl) s += p_modp[(size_t)sl * NMOD + j];
            const int seg = j / DMODEL; p_mod[j] = (seg == 2 || seg == 8) ? 0.5f * s : s;
            if (seg == 4) p_GM[j - 4 * DMODEL] = INP(9)[j - 4 * DMODEL] * (1.0f + s);
            if (seg == 7) p_GM[DMODEL + j - 7 * DMODEL] = INP(30)[j - 7 * DMODEL] * (1.0f + s); }
    }
    SEAM(1);
    if (IN(2)) { const int lane = lane_asm(), tid = wave * 64 + lane; (void)tid; norm_mod_pass(p_x, INP(5), p_mod + 1 * DMODEL, p_mod + 0 * DMODEL, p_HB, gw, NGW, lane);
        for (int i = bx * NTHR + tid; i < 2 * M; i += G * NTHR) p_SSQ[i] = 0ull;
        for (int p = gw; p < 65536; p += NGW) ((unsigned*)(p_UGS + (size_t)p * 384 + 256))[lane] = 0u;
#pragma unroll
        for (int which = 0; which < 2; ++which) { const bf16* Wt = which == 0 ? p_WIN : p_W2U; const float* shv = p_mod + (which == 0 ? 3 : 6) * DMODEL; float* bvo = p_BV + (which == 0 ? 0 : NIN); const int nrows = which == 0 ? NIN : NUP;
            float shr[32];
#pragma unroll
            for (int j = 0; j < 4; ++j)
#pragma unroll
                for (int e = 0; e < 8; ++e) shr[j * 8 + e] = shv[j * 512 + lane * 8 + e];
            for (int r = gw; r < nrows; r += 4 * NGW) {
                v4u w[4][4];
#pragma unroll
                for (int q = 0; q < 4; ++q) { const int rq = (r + q * NGW < nrows) ? r + q * NGW : r; const bf16* wr_ = Wt + (size_t)rq * DMODEL + lane * 8;
#pragma unroll
                    for (int j = 0; j < 4; ++j) w[q][j] = *(const v4u*)(wr_ + j * 512); }
#pragma unroll
                for (int q = 0; q < 4; ++q) { float acc = 0.f;
#pragma unroll
                    for (int j = 0; j < 4; ++j) { const v4u x = w[q][j];
                        acc += blo(x.x) * shr[j * 8 + 0] + bhi(x.x) * shr[j * 8 + 1] + blo(x.y) * shr[j * 8 + 2] + bhi(x.y) * shr[j * 8 + 3] + blo(x.z) * shr[j * 8 + 4] + bhi(x.z) * shr[j * 8 + 5] + blo(x.w) * shr[j * 8 + 6] + bhi(x.w) * shr[j * 8 + 7]; }
                    acc = wave_sum(acc); if (lane == 0 && r + q * NGW < nrows) bvo[r + q * NGW] = acc; } } }
    }
    SEAM(2);
    if (IN(3)) { pg8::Gemm g{p_HB, p_W1U, DMODEL, DMODEL, DMODEL, 0, 0}; pg8::StaticOrder S; S.init(M, NUP, G, bx); pg8::EpiSwiGLU<false> Ep{p_H, FF, nullptr, nullptr};
        pg8::gemm_phase<pg8::EpiSwiGLU<false>, pg8::StaticOrder, true, true>(L, g, S, Ep, wave); }
    SEAM(3);
    if (IN(4)) { pg8::Gemm g{p_H, p_W1D, FF, FF, FF, 0, 0}; pg8::StaticOrder S; S.init(M, DMODEL, G, bx); pg8::EpiResid<true> Ep{p_x, p_out, DMODEL, p_mod + 2 * DMODEL, p_HB, p_GM, p_SSQ};
        pg8::gemm_phase<pg8::EpiResid<true>, pg8::StaticOrder, true, true>(L, g, S, Ep, wave); }
    SEAM(4);
    if (IN(6)) { pg8::Gemm g{p_HB, p_WIN, DMODEL, DMODEL, DMODEL, 0, 0}; pg8::StaticOrder S; S.init(M, NIN, G, bx); pg8::EpiQKVU Ep{p_Q, (size_t)(WS_K - WS_Q) / 2, p_UGS, INP(11), INP(12), p_CS, attn_body::C2, p_SSQ, p_BV};
        pg8::gemm_phase<pg8::EpiQKVU, pg8::StaticOrder, true, true>(L, g, S, Ep, wave); }
    SEAM(6);
    if (IN(7)) { const int lane = lane_asm(), tid = wave * 64 + lane; (void)tid;
        pg8::Gemm g{p_UGS, p_BE, 64 * 384, 768, 768, 768, (size_t)256 * 768}; pg8::BatchOrder S; S.init(4, 32, G, bx); pg8::EpiF32 Ep{p_E, 8192};
        pg8::gemm_phase<pg8::EpiF32, pg8::BatchOrder, true, true>(L, g, S, Ep, wave);
    }
    SEAM(7);
    if (IN(8)) { const int lane = lane_asm();
        for (int b = bx; b < 256; b += G) { const int g = b >> 2, p = (b & 3) * 16 + (lane & 15), sub = lane >> 4, sg = wave * 4 + sub; LAS float* sl = (LAS float*)L;
            const float ar = p_A16[(g * 64 + p) * 2], ai = p_A16[(g * 64 + p) * 2 + 1];
            const float* Eg = p_E + g * 128 + p + (size_t)(sg * 32) * 8192;
            float sr = 0.f, si = 0.f;
            float er[32], ei[32];
#pragma unroll
            for (int k = 0; k < 32; ++k) { er[k] = Eg[(size_t)k * 8192]; ei[k] = Eg[(size_t)k * 8192 + 64]; }
#pragma unroll
            for (int k = 0; k < 32; ++k) { const float nr = ar * sr - ai * si + er[k], ni = ar * si + ai * sr + ei[k]; sr = nr; si = ni; }
            sl[(sg * 2) * 16 + (lane & 15)] = sr; sl[(sg * 2 + 1) * 16 + (lane & 15)] = si;
            float pr = ar, pi = ai;
#pragma unroll
            for (int k = 0; k < 5; ++k) { const float t = pr * pr - pi * pi; pi = 2.0f * pr * pi; pr = t; }
            __syncthreads();
            float ir = 0.f, ii = 0.f;
            for (int w2 = 0; w2 < 32; ++w2) { if (w2 < sg) { const float lr = sl[(w2 * 2) * 16 + (lane & 15)], li = sl[(w2 * 2 + 1) * 16 + (lane & 15)]; const float nr = pr * ir - pi * ii + lr, ni = pr * ii + pi * ir + li; ir = nr; ii = ni; } }
            sr = ir; si = ii;
            bf16* Ug = p_UGS + (size_t)g * 384 + 256 + p + (size_t)(sg * 32) * (64 * 384);
#pragma unroll
            for (int k = 0; k < 32; ++k) { const size_t o = (size_t)k * (64 * 384); Ug[o] = (bf16)f2bf(sr); Ug[o + 64] = (bf16)f2bf(si);
                const float nr = ar * sr - ai * si + er[k], ni = ar * si + ai * sr + ei[k]; sr = nr; si = ni; }
            __syncthreads();
        }
    }
    SEAM(8);
    if (IN(9)) {
#ifndef P9_NO_SSMY
        { pg8::Gemm g{p_UGS, p_BY, 64 * 384, 384, 384, 384, (size_t)256 * 384}; pg8::BatchOrder S; S.init(4, 64, G, bx); pg8::EpiSsmY Ep{p_UGS, INP(25), p_YG};
          pg8::gemm_phase<pg8::EpiSsmY, pg8::BatchOrder, true, true>(L, g, S, Ep, wave); }
#endif
#ifndef P9_NO_ATTN
        const attn_body::AttnTensors AT{(const attn_body::bf16*)p_Q, (const attn_body::bf16*)p_K, (const attn_body::bf16*)p_V, (attn_body::bf16*)p_O32, p_cid, INP(11), INP(12)};
        const attn_body::StaticOrder S(G, bx);
        attn_body::attn_phase<attn_body::StaticOrder>((char*)lds, AT, S, wave);
#ifdef PROBE_REP_ATTN
        attn_body::attn_phase<attn_body::StaticOrder>((char*)lds, AT, S, wave);
#endif
#endif
    }
    SEAM(9);
    if (IN(10)) { pg8::Gemm g{p_YG, p_WGLU, 1024, 1024, 1024, 0, 0}; pg8::StaticOrder S; S.init(M, 1024, G, bx); pg8::EpiGlu Ep{p_YG, INP(27), p_Y2};
        pg8::gemm_phase<pg8::EpiGlu, pg8::StaticOrder, true, true>(L, g, S, Ep, wave); }
    SEAM(10);
    if (IN(11)) { const int lane = lane_asm(), tid = wave * 64 + lane; (void)tid;
        const float s1 = wave_sum((INP(13))[lane] * (INP(14))[lane]), s2 = wave_sum((INP(15))[lane] * (INP(16))[lane]);
        const float lam_init = 0.2f, lam = expf(s1) - expf(s2) + lam_init;
        float subln[16], ogn[16];
        { const float* sp_ = INP(17) + (lane & 7) * 16; const float* gp_ = INP(28) + lane * 16;
#pragma unroll
          for (int i = 0; i < 16; ++i) { subln[i] = sp_[i]; ogn[i] = gp_[i]; } }
#define MIX_LOAD(dst, rowA) do { _Pragma("unroll") for (int q = 0; q < 2; ++q) { const int rr_ = (rowA) + q * NGW; const size_t ro = (size_t)(rr_ < M ? rr_ : ((rowA) < M ? (rowA) : gw)) * 1024 + lane * 16; \
                dst[q][0] = *(const v4u*)(p_O32 + ro); dst[q][1] = *(const v4u*)(p_O32 + ro + 8); \
                dst[q][2] = *(const v4u*)(p_O32 + (size_t)M * 1024 + ro); dst[q][3] = *(const v4u*)(p_O32 + (size_t)M * 1024 + ro + 8); \
                dst[q][4] = *(const v4u*)(p_Y2 + ro); dst[q][5] = *(const v4u*)(p_Y2 + ro + 8); } } while (0)
        v4u w[2][6], wn[2][6];
        MIX_LOAD(w, gw);
        for (int row = gw; row < M; row += 2 * NGW) {
            const int r1 = (row + NGW < M) ? row + NGW : row;
            MIX_LOAD(wn, row + 2 * NGW);
            asm volatile("" ::: "memory");
#pragma unroll
            for (int q = 0; q < 2; ++q) { const int r = (q == 0 ? row : r1);
                float a[16], b[16];
#define UNP(dst, lo_, hi_) do { dst[0] = blo(lo_.x); dst[1] = bhi(lo_.x); dst[2] = blo(lo_.y); dst[3] = bhi(lo_.y); dst[4] = blo(lo_.z); dst[5] = bhi(lo_.z); dst[6] = blo(lo_.w); dst[7] = bhi(lo_.w); \
                    dst[8] = blo(hi_.x); dst[9] = bhi(hi_.x); dst[10] = blo(hi_.y); dst[11] = bhi(hi_.y); dst[12] = blo(hi_.z); dst[13] = bhi(hi_.z); dst[14] = blo(hi_.w); dst[15] = bhi(hi_.w); } while (0)
                UNP(a, w[q][0], w[q][1]); UNP(b, w[q][2], w[q][3]);
                float ss = 0.f;
#pragma unroll
                for (int i = 0; i < 16; ++i) { a[i] = a[i] - lam * b[i]; ss += a[i] * a[i]; }
                ss += __shfl_xor(ss, 1); ss += __shfl_xor(ss, 2); ss += __shfl_xor(ss, 4);
                const float rstd = (1.0f - lam_init) / sqrtf(ss * (1.0f / 128.0f) + 1e-6f);
#pragma unroll
                for (int i = 0; i < 16; ++i) a[i] = a[i] * rstd * subln[i];
                pack16(p_MIX + (size_t)r * DMODEL + lane * 16, a);
                UNP(b, w[q][4], w[q][5]); float s3 = 0.f;
#undef UNP
#pragma unroll
                for (int i = 0; i < 16; ++i) s3 += b[i] * b[i];
                const float r2 = 1.0f / sqrtf(wave_sum(s3) * (1.0f / 1024.0f) + 1e-6f);
#pragma unroll
                for (int i = 0; i < 16; ++i) b[i] = b[i] * r2 * ogn[i];
                pack16(p_MIX + (size_t)r * DMODEL + 1024 + lane * 16, b); }
#pragma unroll
            for (int q = 0; q < 2; ++q)
#pragma unroll
                for (int i = 0; i < 6; ++i) w[q][i] = wn[q][i];
        }
#undef MIX_LOAD
    }
    SEAM(11);
    if (IN(12)) { pg8::Gemm g{p_MIX, p_WOUT, DMODEL, DMODEL, DMODEL, 0, 0}; pg8::StaticOrder S; S.init(M, DMODEL, G, bx); pg8::EpiResid<true> Ep{p_out, p_out, DMODEL, p_mod + 5 * DMODEL, p_HB, p_GM + DMODEL, p_SSQ + M};
        pg8::gemm_phase<pg8::EpiResid<true>, pg8::StaticOrder, true, true>(L, g, S, Ep, wave); }
    SEAM(12);
    if (IN(14)) { pg8::Gemm g{p_HB, p_W2U, DMODEL, DMODEL, DMODEL, 0, 0}; pg8::StaticOrder S; S.init(M, NUP, G, bx); pg8::EpiSwiGLU<true> Ep{p_H, FF, p_SSQ + M, p_BV + NIN};
        pg8::gemm_phase<pg8::EpiSwiGLU<true>, pg8::StaticOrder, true, true>(L, g, S, Ep, wave); }
    SEAM(14);
    if (IN(15)) { pg8::Gemm g{p_H, p_W2D, FF, FF, FF, 0, 0}; pg8::StaticOrder S; S.init(M, DMODEL, G, bx); pg8::EpiResid<false> Ep{p_out, p_out, DMODEL, p_mod + 8 * DMODEL, nullptr, nullptr, nullptr};
        pg8::gemm_phase<pg8::EpiResid<false>, pg8::StaticOrder, true, true>(L, g, S, Ep, wave); }
    if (hi - lo == NPH && bx == 0 && wave == 0 && lane_asm() == 0) __hip_atomic_store((unsigned*)p_ws + FB_REL, 2u, __ATOMIC_RELAXED, __HIP_MEMORY_SCOPE_AGENT);
#undef IN
#undef SEAM
#undef p_x
#undef p_cvec
#undef p_pos
#undef p_w_ada
#undef p_b_ada
#undef p_out
#undef p_ws
#undef p_modp
#undef p_mod
#undef p_cid
#undef p_A16
#undef p_CS
#undef p_SSQ
#undef p_BV
#undef p_GM
#undef p_W1U
#undef p_W1D
#undef p_W2U
#undef p_W2D
#undef p_WIN
#undef p_WOUT
#undef p_WGLU
#undef p_BE
#undef p_BY
#undef p_HB
#undef p_H
#undef p_Q
#undef p_K
#undef p_V
#undef p_UGS
#undef p_E
#undef p_O32
#undef p_YG
#undef p_Y2
#undef p_MIX
#undef INP
}

extern "C" void kernel_launch(void* const* d_in, const int* in_sizes, int n_in, void* d_out, int out_size, void* d_ws, size_t ws_size, hipStream_t stream) {
    static int grid = 0;
    if (grid == 0) {
        if (n_in != 34 || in_sizes[0] != M * DMODEL || out_size != M * DMODEL || ws_size < WS_END) { fprintf(stderr, "kernel_launch: unexpected shapes (n_in %d, ws %zu)\n", n_in, ws_size); grid = -1; return; }
        int dev = 0, cus = 0, per_cu = 0;
        (void)hipGetDevice(&dev); (void)hipDeviceGetAttribute(&cus, hipDeviceAttributeMultiprocessorCount, dev);
        (void)hipFuncSetAttribute((const void*)mk_fwd, hipFuncAttributeMaxDynamicSharedMemorySize, LDS_BYTES);
        if (hipOccupancyMaxActiveBlocksPerMultiprocessor(&per_cu, (const void*)mk_fwd, NTHR, LDS_BYTES) != hipSuccess || per_cu < 1) per_cu = 1;
        (void)hipGetLastError();
        if (cus <= 0) cus = 256;
        grid = cus * per_cu; if (grid > 256) grid = 256;
    }
    if (grid < 0) return;
    Args a{};
    for (int i = 0; i < 34; ++i) a.in[i] = d_in[i];
    a.out = (float*)d_out; a.ws = (unsigned char*)d_ws;
#if MK_N_LAUNCHES == 1
    a.ph_lo = 0; a.ph_hi = NPH;
    void* kargs[] = {&a};
    hipError_t e = hipLaunchCooperativeKernel((const void*)mk_fwd, dim3(grid), dim3(NTHR), kargs, LDS_BYTES, stream);
    if (e != hipSuccess) {
        fprintf(stderr, "cooperative launch failed: %s (grid %d); falling back to one launch per phase\n", hipGetErrorString(e), grid);
        (void)hipGetLastError();
        for (int ph = 0; ph < NPH; ++ph) { a.ph_lo = ph; a.ph_hi = ph + 1; hipLaunchKernelGGL(mk_fwd, dim3(grid), dim3(NTHR), LDS_BYTES, stream, a); }
    }
#ifdef PROBE_PHASES
    { const int pp[] = {PROBE_PHASES}; for (int ph : pp) { a.ph_lo = ph; a.ph_hi = ph + 1; hipLaunchKernelGGL(mk_fwd, dim3(grid), dim3(NTHR), LDS_BYTES, stream, a); } }
#endif
#else
    for (int ph = 0; ph < NPH; ++ph) { a.ph_lo = ph; a.ph_hi = ph + 1; hipLaunchKernelGGL(mk_fwd, dim3(grid), dim3(NTHR), LDS_BYTES, stream, a); }
#endif
}
```
